# Optimizing an MI355X kernel written in HIP

```python
import math
import jax, jax.numpy as jnp
from jax import lax
import numpy as np

D_MODEL = 1024
BATCH = 8
SEQ = 8192
DEPTH = 2

GRID_W = 64
CTX_LEN = 256
N_HEADS = 8
N_KV_HEADS = 2
HEAD_DIM = D_MODEL // N_HEADS
GQA_GROUP = N_HEADS // N_KV_HEADS
ROPE_THETA = 10000.0
Q_BLOCK = 128
Q_W = N_HEADS * HEAD_DIM
KV_W = N_KV_HEADS * HEAD_DIM
HY_WIDTH = D_MODEL
HY_SHORT = 3
HY_EMB = 33
HY_BANDS = (HY_EMB - 1) // 2
HY_FILTER_HIDDEN = 64
HY_TARGET = 1e-2
HY_FAST_PCT = 0.3
HY_SLOW_PCT = 1.5
HY_MAX_DECAY = math.log(HY_TARGET) / HY_FAST_PCT
HY_MIN_DECAY = math.log(HY_TARGET) / HY_SLOW_PCT
HY_SHIFT = 0.05
POOL_WIDTH = D_MODEL
POOL_WINDOWS = (2, 4, 8, 16)
POOL_GROUP = POOL_WIDTH // len(POOL_WINDOWS)
N_BRANCH = 3
D_FF = -(-8 * D_MODEL // (3 * 256)) * 256
DN_ALPHA = (2 * DEPTH) ** 0.25
DN_BETA = (8 * DEPTH) ** -0.25
EPS = 1e-6

C_Q = 0
C_K = C_Q + Q_W
C_V = C_K + KV_W
C_HY = C_V + KV_W
C_POOL = C_HY + 3 * HY_WIDTH
C_GATE = C_POOL + POOL_WIDTH
IN_WIDTH = C_GATE + N_BRANCH * D_MODEL

kernel_name = 'hybrid_hyena_gqa_pool_dit_block'


def layer_norm(x, g, b):
    xf = x.astype(jnp.float32)
    mu = jnp.mean(xf, axis=-1, keepdims=True)
    var = jnp.mean(jnp.square(xf - mu), axis=-1, keepdims=True)
    return ((xf - mu) * lax.rsqrt(var + EPS) * g + b).astype(x.dtype)


def rms_norm(x, g):
    xf = x.astype(jnp.float32)
    y = xf * lax.rsqrt(jnp.mean(jnp.square(xf), axis=-1, keepdims=True) + EPS)
    return (y * g).astype(x.dtype)


def axial_rope(x, rows, cols):
    half = HEAD_DIM // 2
    quarter = half // 2
    inv = jnp.power(ROPE_THETA, -jnp.arange(quarter, dtype=jnp.float32) / quarter)

    def rot(xh, pos):
        ang = pos.astype(jnp.float32)[:, None] * inv[None, :]
        cos = jnp.cos(ang)[None, :, None, :]
        sin = jnp.sin(ang)[None, :, None, :]
        a, b = xh[..., :quarter], xh[..., quarter:]
        return jnp.concatenate([a * cos - b * sin, b * cos + a * sin], axis=-1)

    xf = x.astype(jnp.float32)
    return jnp.concatenate([rot(xf[..., :half], rows), rot(xf[..., half:], cols)], axis=-1).astype(x.dtype)


def queries(p, q_norm_g):
    B, L = p.shape[0], p.shape[1]
    return rms_norm(p[..., C_Q:C_K].reshape(B, L, N_HEADS, HEAD_DIM), q_norm_g)


def kv_heads(pkv, k_norm_g):
    B, L = pkv.shape[0], pkv.shape[1]
    k = rms_norm(pkv[..., :KV_W].reshape(B, L, N_KV_HEADS, HEAD_DIM), k_norm_g)
    v = pkv[..., KV_W:].reshape(B, L, N_KV_HEADS, HEAD_DIM)
    return k, v


def block_attention(q, k, v):
    B, Lq = q.shape[0], q.shape[1]
    nb = Lq // Q_BLOCK
    qb = q.reshape(B, nb, Q_BLOCK, N_KV_HEADS, GQA_GROUP, HEAD_DIM).transpose(1, 0, 2, 3, 4, 5)
    kf = k.astype(jnp.float32)
    vf = v.astype(jnp.float32)
    scale = HEAD_DIM ** -0.5

    def one_block(qi):
        s = jnp.einsum('bqkgd,btkd->bkgqt', qi.astype(jnp.float32), kf) * scale
        pr = jax.nn.softmax(s, axis=-1)
        return jnp.einsum('bkgqt,btkd->bqkgd', pr, vf)

    o = lax.map(one_block, qb)
    return o.transpose(1, 0, 2, 3, 4, 5).reshape(B, Lq, Q_W).astype(q.dtype)


def hyena_kernel(L, w1, b1, freq, w2, b2, w3):
    f32 = jnp.float32
    t_idx = jnp.arange(L, dtype=f32)
    t01 = t_idx / max(L - 1, 1)
    bands = jnp.linspace(1e-4, HY_BANDS - 1, HY_BANDS, dtype=f32)
    ang = (2.0 * math.pi / L) * t_idx[:, None] * bands[None, :]
    feats = jnp.concatenate([t01[:, None], jnp.cos(ang), -jnp.sin(ang)], axis=-1)
    h = jnp.sin(freq * (feats @ w1 + b1))
    h = jnp.sin(freq * (h @ w2 + b2))
    h = (h @ w3).astype(f32)
    deltas = jnp.abs(jnp.linspace(HY_MIN_DECAY, HY_MAX_DECAY, HY_WIDTH, dtype=f32))
    window = jnp.exp(-t01[:, None] * deltas[None, :]) + HY_SHIFT
    h_fwd = h[:, :HY_WIDTH] * window
    h_bwd = h[:, HY_WIDTH:] * window
    kern = jnp.concatenate([h_fwd, jnp.zeros((1, HY_WIDTH), f32), h_bwd[:0:-1]], axis=0)
    return kern * lax.rsqrt(jnp.sum(jnp.square(kern), axis=0, keepdims=True) + EPS)


def hyena_mixer(u, lp):
    B, L, _ = u.shape
    pad = HY_SHORT // 2
    up = jnp.pad(u, ((0, 0), (pad, HY_SHORT - 1 - pad), (0, 0)))
    s = lp['hy_conv_b']
    for j in range(HY_SHORT):
        s = s + up[:, j:j + L] * lp['hy_conv_w'][j]
    v, x0, x1 = jnp.split(s, 3, axis=-1)
    z = (v * x1).astype(jnp.float32)
    kern = hyena_kernel(L, lp['hf_w1'], lp['hf_b1'], lp['hf_freq'], lp['hf_w2'], lp['hf_b2'], lp['hf_w3'])
    n = 2 * L
    zf = jnp.fft.rfft(z, n=n, axis=1)
    kf = jnp.fft.rfft(kern, n=n, axis=0)
    y = jnp.fft.irfft(zf * kf[None], n=n, axis=1)[:, :L]
    y = y + z * lp['hy_d'].astype(jnp.float32)
    return (y * x0.astype(jnp.float32)).astype(u.dtype)


def pool_mixer(u, pool_w, pool_scale):
    B, L, C = u.shape
    uf = u.astype(jnp.float32)
    cs = jnp.concatenate([jnp.zeros((B, 1, C), jnp.float32), jnp.cumsum(uf, axis=1)], axis=1)
    t = jnp.arange(L)
    outs = []
    for gi, w in enumerate(POOL_WINDOWS):
        before = w // 2
        after = w - 1 - before
        lo = jnp.clip(t - before, 0, L)
        hi = jnp.clip(t + after + 1, 0, L)
        csg = cs[..., gi * POOL_GROUP:(gi + 1) * POOL_GROUP]
        cnt = (hi - lo).astype(jnp.float32)[None, :, None]
        mean = (csg[:, hi] - csg[:, lo]) / cnt
        outs.append(mean - uf[..., gi * POOL_GROUP:(gi + 1) * POOL_GROUP])
    m = jnp.stack(outs, axis=2)
    y = jnp.einsum('blgc,gcd->blgd', m, pool_w.astype(jnp.float32)).reshape(B, L, C)
    return (y * pool_scale).astype(u.dtype)


def stream_mixer(p, q, k_all, v_all, lp):
    attn = block_attention(q, k_all, v_all)
    hy = hyena_mixer(p[..., C_HY:C_POOL], lp)
    pool = pool_mixer(p[..., C_POOL:C_GATE], lp['pool_w'], lp['pool_scale'])
    gates = jax.nn.sigmoid(p[..., C_GATE:].astype(jnp.float32)).astype(p.dtype)
    wb = lp['w_branch']
    merged = (gates[..., :D_MODEL] * (hy @ wb[0])
              + gates[..., D_MODEL:2 * D_MODEL] * (attn @ wb[1])
              + gates[..., 2 * D_MODEL:] * (pool @ wb[2]))
    return merged @ lp['w_out']


def swiglu(h, lp):
    return (jax.nn.silu(h @ lp['ffn_w1']) * (h @ lp['ffn_w3'])) @ lp['ffn_w2']


def trunk_layer(xl, xc, c, c_ctx, rows, cols, lp, last):
    mod_l = (jax.nn.silu(c) @ lp['w_ada'] + lp['b_ada'])[:, None, :]
    mod_c = jax.nn.silu(c_ctx) @ lp['w_ada'] + lp['b_ada']
    sh1_l, sc1_l, g1_l, sh2_l, sc2_l, g2_l = jnp.split(mod_l, 6, axis=-1)
    sh1_c, sc1_c, g1_c, sh2_c, sc2_c, g2_c = jnp.split(mod_c, 6, axis=-1)

    hl = xl * (1 + sc1_l) + sh1_l
    hc = xc * (1 + sc1_c) + sh1_c
    pl = hl @ lp['w_in']
    if last:
        kc, vc = kv_heads(hc @ lp['w_in'][:, C_K:C_HY], lp['k_norm_g'])
    else:
        pc = hc @ lp['w_in']
        kc, vc = kv_heads(pc[..., C_K:C_HY], lp['k_norm_g'])

    ql = axial_rope(queries(pl, lp['q_norm_g']), rows, cols)
    kl, vl = kv_heads(pl[..., C_K:C_HY], lp['k_norm_g'])
    kl = axial_rope(kl, rows, cols)
    k_all = jnp.concatenate([kc, kl], axis=1)
    v_all = jnp.concatenate([vc, vl], axis=1)
    xl = layer_norm(DN_ALPHA * xl + g1_l * stream_mixer(pl, ql, k_all, v_all, lp), lp['ln1_g'], lp['ln1_b'])
    xl = layer_norm(DN_ALPHA * xl + g2_l * swiglu(xl * (1 + sc2_l) + sh2_l, lp), lp['ln2_g'], lp['ln2_b'])

    if not last:
        qc = queries(pc, lp['q_norm_g'])
        xc = layer_norm(DN_ALPHA * xc + g1_c * stream_mixer(pc, qc, kc, vc, lp), lp['ln1_g'], lp['ln1_b'])
        xc = layer_norm(DN_ALPHA * xc + g2_c * swiglu(xc * (1 + sc2_c) + sh2_c, lp), lp['ln2_g'], lp['ln2_b'])
    return xl, xc


def setup_inputs(seed: int = 0) -> dict:
    key = jax.random.key(seed)
    ks = jax.random.split(key, 32)
    f32 = jnp.float32
    L = DEPTH
    D = D_MODEL

    def nrm(k, shape, s):
        return jax.random.normal(k, shape, f32) * s

    return {
        'x': nrm(ks[0], (BATCH, SEQ, D), 1.0),
        'c': nrm(ks[1], (BATCH, D), 1.0),
        'ctx': nrm(ks[2], (BATCH, CTX_LEN, D), 1.0),
        'c_ctx': nrm(ks[3], (D,), 1.0),
        'w_ada': nrm(ks[4], (L, D, 6 * D), 0.5 * D ** -0.5),
        'b_ada': nrm(ks[5], (L, 6 * D), 0.01),
        'w_in': nrm(ks[6], (L, D, IN_WIDTH), D ** -0.5),
        'q_norm_g': 1.0 + nrm(ks[7], (L, HEAD_DIM), 0.02),
        'k_norm_g': 1.0 + nrm(ks[8], (L, HEAD_DIM), 0.02),
        'hy_conv_w': nrm(ks[9], (L, HY_SHORT, 3 * HY_WIDTH), HY_SHORT ** -0.5),
        'hy_conv_b': nrm(ks[10], (L, 3 * HY_WIDTH), 0.02),
        'hf_w1': nrm(ks[11], (L, HY_EMB, HY_FILTER_HIDDEN), HY_EMB ** -0.5),
        'hf_b1': nrm(ks[12], (L, HY_FILTER_HIDDEN), 0.02),
        'hf_freq': 1.0 + nrm(ks[13], (L, HY_FILTER_HIDDEN), 0.02),
        'hf_w2': nrm(ks[14], (L, HY_FILTER_HIDDEN, HY_FILTER_HIDDEN), HY_FILTER_HIDDEN ** -0.5),
        'hf_b2': nrm(ks[15], (L, HY_FILTER_HIDDEN), 0.02),
        'hf_w3': nrm(ks[16], (L, HY_FILTER_HIDDEN, 2 * HY_WIDTH), HY_FILTER_HIDDEN ** -0.5),
        'hy_d': nrm(ks[17], (L, HY_WIDTH), 0.5),
        'pool_w': nrm(ks[18], (L, len(POOL_WINDOWS), POOL_GROUP, POOL_GROUP), POOL_GROUP ** -0.5),
        'pool_scale': 1.0 + nrm(ks[19], (L, POOL_WIDTH), 0.05),
        'w_branch': nrm(ks[20], (L, N_BRANCH, D, D), D ** -0.5),
        'w_out': nrm(ks[21], (L, D, D), D ** -0.5 * DN_BETA),
        'ln1_g': 1.0 + nrm(ks[22], (L, D), 0.02),
        'ln1_b': nrm(ks[23], (L, D), 0.02),
        'ln2_g': 1.0 + nrm(ks[24], (L, D), 0.02),
        'ln2_b': nrm(ks[25], (L, D), 0.02),
        'ffn_w1': nrm(ks[26], (L, D, D_FF), D ** -0.5),
        'ffn_w3': nrm(ks[27], (L, D, D_FF), D ** -0.5),
        'ffn_w2': nrm(ks[28], (L, D_FF, D), D_FF ** -0.5 * DN_BETA),
    }


def reference(x, c, ctx, c_ctx, w_ada, b_ada, w_in, q_norm_g, k_norm_g, hy_conv_w, hy_conv_b,
              hf_w1, hf_b1, hf_freq, hf_w2, hf_b2, hf_w3, hy_d, pool_w, pool_scale, w_branch, w_out,
              ln1_g, ln1_b, ln2_g, ln2_b, ffn_w1, ffn_w3, ffn_w2):
    n_tok = x.shape[1]
    ROWS = n_tok // GRID_W
    rows = jnp.repeat(jnp.arange(ROWS), GRID_W)
    cols = jnp.tile(jnp.arange(GRID_W), ROWS)
    xl, xc = x, ctx
    for l in range(DEPTH):
        lp = dict(w_ada=w_ada[l], b_ada=b_ada[l], w_in=w_in[l], q_norm_g=q_norm_g[l], k_norm_g=k_norm_g[l],
                  hy_conv_w=hy_conv_w[l], hy_conv_b=hy_conv_b[l], hf_w1=hf_w1[l], hf_b1=hf_b1[l],
                  hf_freq=hf_freq[l], hf_w2=hf_w2[l], hf_b2=hf_b2[l], hf_w3=hf_w3[l], hy_d=hy_d[l],
                  pool_w=pool_w[l], pool_scale=pool_scale[l], w_branch=w_branch[l], w_out=w_out[l],
                  ln1_g=ln1_g[l], ln1_b=ln1_b[l], ln2_g=ln2_g[l], ln2_b=ln2_b[l],
                  ffn_w1=ffn_w1[l], ffn_w3=ffn_w3[l], ffn_w2=ffn_w2[l])
        xl, xc = trunk_layer(xl, xc, c, c_ctx, rows, cols, lp, l == DEPTH - 1)
    return xl
```

```cpp
#include <hip/hip_runtime.h>
#include <hip/hip_cooperative_groups.h>
#include <cstdio>
#include <cstdint>
namespace cg = cooperative_groups;
#ifndef PROBE_SYNC
#define PROBE_SYNC 0
#endif
#ifndef PROBE_FFT
#define PROBE_FFT 0
#endif
#ifndef PROBE_ATT
#define PROBE_ATT 0
#endif
#ifndef PROBE_GEMM
#define PROBE_GEMM 0
#endif
#ifndef PROBE_PREP
#define PROBE_PREP 0
#endif
#ifndef PROBE_EW
#define PROBE_EW 0
#endif
#define GSYNC() do { XcdBarrier xb_; xb_.bar = (unsigned*)(p.ws + OFF_BAR); xb_.x = xb_xcc_id(); xb_.st = (volatile LAS unsigned*)(LAS unsigned char*)(lds + LDS_BYTES - 16); xcd_barrier(xb_); if (PROBE_SYNC) xcd_barrier(xb_); } while (0)

#define DEVI __device__ __forceinline__
#define LAS __attribute__((address_space(3)))
typedef unsigned short bf16_t;
typedef short bf16x8 __attribute__((ext_vector_type(8)));
typedef short s16x4 __attribute__((ext_vector_type(4)));
typedef float f32x4 __attribute__((ext_vector_type(4)));
typedef float f32x16 __attribute__((ext_vector_type(16)));
typedef unsigned u32x4 __attribute__((ext_vector_type(4)));
typedef unsigned u32x2 __attribute__((ext_vector_type(2)));

constexpr int DM = 1024, NBATCH = 8, SEQ = 8192, CTXL = 256, NHEAD = 8, HD = 128;
constexpr int INW = 8704, C_Q = 0, C_K = 1024, C_V = 1280, C_HY = 1536, C_POOL = 4608, C_GATE = 5632;
constexpr int DFF = 2816;
constexpr int NLAT = NBATCH * SEQ, NCTX = NBATCH * CTXL, NTOK = NLAT + NCTX;
constexpr int CH_ROWS = 16384;
constexpr int KVLEN = SEQ + CTXL;
constexpr float DN_ALPHA = 1.4142135623730951f;
constexpr float EPSF = 1e-6f;
constexpr int NTHR = 512;
constexpr int FFTN = 16384;
constexpr int LDS_BYTES = 132 * 1024;

constexpr size_t al256(size_t x) { return (x + 255) / 256 * 256; }
constexpr size_t SZ_WIN = (size_t)INW * DM * 2, SZ_WBR = (size_t)3 * DM * DM * 2, SZ_WOUT = (size_t)DM * DM * 2, SZ_W13 = (size_t)2 * DFF * DM * 2, SZ_W2 = (size_t)DM * DFF * 2;
constexpr size_t OFF_WIN = 0;
constexpr size_t OFF_WBR = OFF_WIN + 2 * SZ_WIN;
constexpr size_t OFF_WOUT = OFF_WBR + 2 * SZ_WBR;
constexpr size_t OFF_W13 = OFF_WOUT + 2 * SZ_WOUT;
constexpr size_t OFF_W2 = OFF_W13 + 2 * SZ_W13;
constexpr size_t OFF_MODP = OFF_W2 + 2 * SZ_W2;
constexpr size_t OFF_MOD = OFF_MODP + (size_t)2 * 16 * 9 * 6144 * 4;
constexpr size_t OFF_ROPE = OFF_MOD + (size_t)2 * 9 * 6144 * 4;
constexpr size_t SZ_KF = (size_t)1024 * FFTN * 8;
constexpr size_t OFF_KF = OFF_ROPE + (size_t)128 * 32 * 8;
constexpr size_t OFF_KC = OFF_KF + 2 * SZ_KF;
constexpr size_t OFF_H = OFF_KC + (size_t)1024 * 512 * 4;
constexpr size_t OFF_XLC = OFF_H + (size_t)NTOK * DM * 2;
constexpr size_t OFF_P = OFF_XLC + (size_t)NCTX * DM * 4;
constexpr size_t OFF_ZT = OFF_P + (size_t)CH_ROWS * INW * 2;
constexpr size_t OFF_KALL = OFF_ZT + (size_t)2 * 1024 * SEQ * 2;
constexpr size_t OFF_VALL = OFF_KALL + (size_t)NBATCH * KVLEN * 256 * 2;
constexpr size_t OFF_R2 = OFF_VALL + (size_t)NBATCH * KVLEN * 256 * 2;
constexpr size_t OFF_BAR = OFF_R2 + (size_t)2 * CH_ROWS * DM * 2;
constexpr size_t WS_END = OFF_BAR + 16384;

struct Params { const float* in[29]; float* out; unsigned char* ws; };
enum { I_X = 0, I_C, I_CTX, I_CCTX, I_WADA, I_BADA, I_WIN, I_QG, I_KG, I_HCW, I_HCB, I_HW1, I_HB1, I_HFREQ, I_HW2, I_HB2, I_HW3, I_HYD, I_POOLW, I_POOLS, I_WBR, I_WOUT,
       I_LN1G, I_LN1B, I_LN2G, I_LN2B, I_FW1, I_FW3, I_FW2 };

DEVI int opq_s(int x) { asm volatile("" : "+s"(x)); return x; }
DEVI int opq_v(int x) { asm volatile("" : "+v"(x)); return x; }
DEVI float bf2f(unsigned short b) { return __uint_as_float(((unsigned)b) << 16); }
DEVI unsigned cvt_pk_bf16(float lo, float hi) { unsigned r; asm volatile("v_cvt_pk_bf16_f32 %0, %1, %2" : "=v"(r) : "v"(lo), "v"(hi)); return r; }
DEVI u32x4 pack8(const float* v) { u32x4 w; w.x = cvt_pk_bf16(v[0], v[1]); w.y = cvt_pk_bf16(v[2], v[3]); w.z = cvt_pk_bf16(v[4], v[5]); w.w = cvt_pk_bf16(v[6], v[7]); return w; }
DEVI void unpack8(u32x4 w, float* o) {
    o[0] = __uint_as_float(w.x << 16); o[1] = __uint_as_float(w.x & 0xffff0000u); o[2] = __uint_as_float(w.y << 16); o[3] = __uint_as_float(w.y & 0xffff0000u);
    o[4] = __uint_as_float(w.z << 16); o[5] = __uint_as_float(w.z & 0xffff0000u); o[6] = __uint_as_float(w.w << 16); o[7] = __uint_as_float(w.w & 0xffff0000u); }
DEVI void ld8bf(const bf16_t* p, float* o) { unpack8(*(const u32x4*)p, o); }
DEVI float sigmoidf_(float x) { return __builtin_amdgcn_rcpf(1.f + __expf(-x)); }
DEVI float wave_sum(float v) { for (int m = 32; m >= 1; m >>= 1) v += __shfl_xor(v, m); return v; }

struct Chunk { int isctx, nrows, L, lgL, b0, row0g, koff; float* xl; };
DEVI Chunk mk_chunk(int ci, const Params& p) {
    Chunk c;
    if (ci < 0) { c.isctx = 1; c.nrows = NCTX; c.L = CTXL; c.lgL = 8; c.b0 = 0; c.row0g = NLAT; c.koff = 0; c.xl = (float*)(p.ws + OFF_XLC); }
    else { c.isctx = 0; c.nrows = CH_ROWS; c.L = SEQ; c.lgL = 13; c.b0 = 2 * ci; c.row0g = ci * CH_ROWS; c.koff = CTXL; c.xl = p.out + (size_t)ci * CH_ROWS * DM; }
    return c;
}

namespace pg8 {
constexpr int BM = 256, BK = 64, HALF = 128, HTB = HALF * BK * 2, STAGE_BYTES = 8 * HTB, NXCD = 8, WGM = 8;
DEVI int lds_byte(int r, int c) { const int st = (r >> 4) * 2 + (c >> 5), rr = r & 15, cc = c & 31, ob = rr * 64 + cc * 2; return st * 1024 + (ob ^ (((ob >> 9) & 1) << 5)); }
DEVI void stage_rc(int b, int& R, int& C) { const int st = b / 1024, sb = b % 1024, swz = sb ^ (((sb >> 9) & 1) << 5); R = (st >> 1) * 16 + swz / 64; C = (st & 1) * 32 + (swz % 64) / 2; }
DEVI int perm32(int rho) { const int n = rho >> 4, i = rho & 15; return 8 * (i >> 2) + 4 * n + (i & 3); }
struct Unit { int pm, pn, seg; };
struct Gemm { const bf16_t* A; const bf16_t* Bt; int M, N, K, lda; unsigned a0, a1, a2; size_t bseg; };
struct StaticOrder {
    int nM, nN, nwg, G, c, nseg;
    DEVI void init(int M, int N, int G_, int c_, int nseg_ = 1) { nM = M / BM; nN = N / BM; nwg = nM * nN; G = G_; c = c_; nseg = nseg_; }
    DEVI bool next(int i, Unit& u) const {
        const int ib = i / nseg; u.seg = i - ib * nseg;
        const long L = (long)ib * G + c; if (L >= nwg) return false;
        int wgid = (int)L; { const int q = nwg / NXCD, r = nwg % NXCD, xcd = wgid % NXCD, off = wgid / NXCD; wgid = (xcd < r ? xcd * (q + 1) : r * (q + 1) + (xcd - r) * q) + off; }
        const int nig = WGM * nN, gid = wgid / nig, fm = gid * WGM, gsz = (nM - fm) < WGM ? (nM - fm) : WGM;
        u.pm = fm + ((wgid % nig) % gsz); u.pn = (wgid % nig) / gsz; return true;
    }
};
template <class Epi>
DEVI void gemm_phase(LAS unsigned char* lds, const Gemm g, const StaticOrder& S, const Epi& E) {
    const int tid = opq_v(threadIdx.x), wid = __builtin_amdgcn_readfirstlane(tid >> 6), lane = tid & 63, wr = wid >> 2, wc = wid & 3, fr = lane & 15, fq = lane >> 4;
    const int K = g.K, nt = K / BK;
    unsigned voffA[2], voffB[2];
#pragma unroll
    for (int i = 0; i < 2; ++i) { int R, C; stage_rc(tid * 16 + i * 8192, R, C); const int Rb = (R & ~31) + perm32(R & 31);
        voffA[i] = (unsigned)(R * g.lda + C) * 2u; voffB[i] = (unsigned)(Rb * K + C) * 2u; }
    const size_t kstep = (size_t)(BK * 2);
    const size_t hstepA = (size_t)HALF * g.lda * 2, hstepB = (size_t)HALF * K * 2;
    const size_t tstepA = 2 * hstepA, tstepB = 2 * hstepB;
    const unsigned ldsw = (unsigned)wid * 1024u;
    const int aoff = lds_byte(wr * 64 + fr, fq * 8), boff = lds_byte(wc * 32 + fr, fq * 8);
#define PG8_SA(b, h) (((b) * 2 + (h)) * HTB)
#define PG8_SB(b, h) ((4 + (b) * 2 + (h)) * HTB)
#define PG8_STAGE(bufoff, gbase, voff) do { _Pragma("unroll") for (int _i = 0; _i < 2; ++_i) \
        __builtin_amdgcn_global_load_lds((const unsigned*)((const char*)(gbase) + (voff)[_i]), (LAS unsigned*)(lds + (bufoff) + ldsw + _i * 8192), 16, 0, 0); } while (0)
#define PG8_LDA(dst, b, h) do { _Pragma("unroll") for (int m = 0; m < 4; ++m) _Pragma("unroll") for (int k = 0; k < 2; ++k) dst[m][k] = *(const LAS bf16x8*)(lds + PG8_SA(b, h) + aoff + m * 2048 + k * 1024); } while (0)
#define PG8_LDB(dst, b, h) do { _Pragma("unroll") for (int n = 0; n < 2; ++n) _Pragma("unroll") for (int k = 0; k < 2; ++k) dst[n][k] = *(const LAS bf16x8*)(lds + PG8_SB(b, h) + boff + n * 2048 + k * 1024); } while (0)
#define PG8_MMA(ai, bj, At, Bt) do { __builtin_amdgcn_s_setprio(1); _Pragma("unroll") for (int m = 0; m < 4; ++m) _Pragma("unroll") for (int n = 0; n < 2; ++n) _Pragma("unroll") for (int k = 0; k < 2; ++k) \
        acc[ai][bj][m][n] = __builtin_amdgcn_mfma_f32_16x16x32_bf16(Bt[n][k], At[m][k], acc[ai][bj][m][n], 0, 0, 0); __builtin_amdgcn_s_setprio(0); } while (0)
#define PG8_WAIT_V(n) asm volatile("s_waitcnt vmcnt(" #n ")" ::: "memory")
#define PG8_WAIT_L(n) asm volatile("s_waitcnt lgkmcnt(" #n ")" ::: "memory")
#define PG8_BAR __builtin_amdgcn_s_barrier()
#define PG8_SCHED __builtin_amdgcn_sched_barrier(0)
    Unit cur, nxt; int ui = 0;
    if (!S.next(0, cur)) return;
    f32x4 acc[2][2][4][2];
#pragma unroll
    for (int a = 0; a < 2; ++a)
#pragma unroll
        for (int b = 0; b < 2; ++b)
#pragma unroll
            for (int m = 0; m < 4; ++m)
#pragma unroll
                for (int n = 0; n < 2; ++n) acc[a][b][m][n] = (f32x4){0.f, 0.f, 0.f, 0.f};
    bf16x8 At[4][2], B0[2][2], B1[2][2];
#define PG8_ABASE(u) ((const char*)g.A + ((u).seg == 0 ? g.a0 : ((u).seg == 1 ? g.a1 : g.a2)) + (size_t)(u).pm * tstepA)
#define PG8_BBASE(u) ((const char*)g.Bt + (size_t)(u).seg * g.bseg + (size_t)(u).pn * tstepB)
    const char* cA = PG8_ABASE(cur); const char* cB = PG8_BBASE(cur);
    PG8_STAGE(PG8_SB(0, 0), cB, voffB); PG8_STAGE(PG8_SA(0, 0), cA, voffA); PG8_STAGE(PG8_SB(0, 1), cB + hstepB, voffB); PG8_STAGE(PG8_SA(0, 1), cA + hstepA, voffA);
    if (wr == 1) PG8_BAR;
    PG8_WAIT_V(4); PG8_BAR;
    PG8_STAGE(PG8_SB(1, 0), cB + kstep, voffB); PG8_STAGE(PG8_SA(1, 0), cA + kstep, voffA); PG8_STAGE(PG8_SB(1, 1), cB + hstepB + kstep, voffB);
    PG8_WAIT_V(6); PG8_BAR;
    for (;;) {
        const bool has_next = S.next(ui + 1, nxt);
        const char* nA = has_next ? PG8_ABASE(nxt) : cA; const char* nB = has_next ? PG8_BBASE(nxt) : cB;
        for (int t = 0; t < nt; t += 2) {
            const bool last = (t == nt - 2);
            const char* a1 = cA + (size_t)(t + 1) * kstep;
            const char* a2 = last ? nA : cA + (size_t)(t + 2) * kstep; const char* b2 = last ? nB : cB + (size_t)(t + 2) * kstep;
            const char* a3 = a2 + kstep; const char* b3 = b2 + kstep;
            PG8_LDB(B0, 0, 0); PG8_SCHED; PG8_LDA(At, 0, 0); PG8_STAGE(PG8_SA(1, 1), a1 + hstepA, voffA);
            PG8_WAIT_L(8); PG8_BAR; PG8_WAIT_L(0); PG8_MMA(0, 0, At, B0); PG8_BAR; PG8_SCHED;
            PG8_LDB(B1, 0, 1); PG8_STAGE(PG8_SB(0, 0), b2, voffB);
            PG8_BAR; PG8_WAIT_L(0); PG8_MMA(0, 1, At, B1); PG8_BAR;
            PG8_LDA(At, 0, 1); PG8_STAGE(PG8_SA(0, 0), a2, voffA);
            PG8_BAR; PG8_WAIT_L(0); PG8_MMA(1, 0, At, B0); PG8_BAR; PG8_SCHED;
            PG8_STAGE(PG8_SB(0, 1), b2 + hstepB, voffB);
            PG8_WAIT_V(6); PG8_BAR; PG8_MMA(1, 1, At, B1); PG8_BAR;
            PG8_LDB(B0, 1, 0); PG8_SCHED; PG8_LDA(At, 1, 0); PG8_STAGE(PG8_SA(0, 1), a2 + hstepA, voffA);
            PG8_WAIT_L(8); PG8_BAR; PG8_WAIT_L(0); PG8_MMA(0, 0, At, B0); PG8_BAR; PG8_SCHED;
            PG8_LDB(B1, 1, 1); PG8_STAGE(PG8_SB(1, 0), b3, voffB);
            PG8_BAR; PG8_WAIT_L(0); PG8_MMA(0, 1, At, B1); PG8_BAR;
            PG8_LDA(At, 1, 1); PG8_STAGE(PG8_SA(1, 0), a3, voffA);
            PG8_BAR; PG8_WAIT_L(0); PG8_MMA(1, 0, At, B0); PG8_BAR; PG8_SCHED;
            PG8_STAGE(PG8_SB(1, 1), b3 + hstepB, voffB);
            PG8_WAIT_V(6); PG8_BAR; PG8_MMA(1, 1, At, B1); PG8_BAR;
        }
        E(acc, cur, wr, wc, fr, fq);
        if (!has_next) break;
#pragma unroll
        for (int a = 0; a < 2; ++a)
#pragma unroll
            for (int b = 0; b < 2; ++b)
#pragma unroll
                for (int m = 0; m < 4; ++m)
#pragma unroll
                    for (int n = 0; n < 2; ++n) acc[a][b][m][n] = (f32x4){0.f, 0.f, 0.f, 0.f};
        cur = nxt; cA = nA; cB = nB; ++ui;
    }
    PG8_WAIT_V(0);
    if (wr == 0) PG8_BAR;
    PG8_BAR;
#undef PG8_ABASE
#undef PG8_BBASE
#undef PG8_SA
#undef PG8_SB
#undef PG8_STAGE
#undef PG8_LDA
#undef PG8_LDB
#undef PG8_MMA
#undef PG8_WAIT_V
#undef PG8_WAIT_L
#undef PG8_BAR
#undef PG8_SCHED
}
}

typedef const f32x4 (&AccRef)[2][2][4][2];
#define EPI_LOOP_BEGIN \
    const int row0 = u.pm * 256 + wr * 64 + fr; const int colu = u.pn * 256 + wc * 32 + 8 * fq; \
    _Pragma("unroll") for (int ai = 0; ai < 2; ++ai) _Pragma("unroll") for (int m = 0; m < 4; ++m) { const int r = row0 + ai * 128 + m * 16; \
    _Pragma("unroll") for (int bj = 0; bj < 2; ++bj) { const int c = colu + bj * 128; float v[8]; \
        v[0] = acc[ai][bj][m][0][0]; v[1] = acc[ai][bj][m][0][1]; v[2] = acc[ai][bj][m][0][2]; v[3] = acc[ai][bj][m][0][3]; \
        v[4] = acc[ai][bj][m][1][0]; v[5] = acc[ai][bj][m][1][1]; v[6] = acc[ai][bj][m][1][2]; v[7] = acc[ai][bj][m][1][3];
#define EPI_LOOP_END } }

struct EpiA {
    bf16_t* P; bf16_t* vall; int lgL, Lm1, b0, koff, col_off;
    DEVI void operator()(AccRef acc, const pg8::Unit& u, int wr, int wc, int fr, int fq) const {
        const int colt = u.pn * 256 + col_off;
        EPI_LOOP_BEGIN
            const int cc = c + col_off;
            if (colt >= C_V && colt < C_HY) { const size_t kvrow = (size_t)(b0 + (r >> lgL)) * KVLEN + koff + (r & Lm1); *(u32x4*)(vall + kvrow * 256 + (cc - C_V)) = pack8(v); }
            else { if (colt >= C_GATE) {
#pragma unroll
                    for (int i = 0; i < 8; ++i) v[i] = sigmoidf_(v[i]); }
                *(u32x4*)(P + (size_t)r * INW + cc) = pack8(v); }
        EPI_LOOP_END
    }
};
struct EpiMerge {
    const bf16_t* P; bf16_t* mg;
    DEVI void operator()(AccRef acc, const pg8::Unit& u, int wr, int wc, int fr, int fq) const {
        const bf16_t* gate = P + C_GATE + u.seg * DM; const bool first = (u.seg == 0);
        EPI_LOOP_BEGIN
            float gv[8]; ld8bf(gate + (size_t)r * INW + c, gv);
            bf16_t* mp = mg + (size_t)r * DM + c;
            float t[8];
            if (first) {
#pragma unroll
                for (int i = 0; i < 8; ++i) t[i] = gv[i] * v[i]; }
            else { float a[8]; ld8bf(mp, a);
#pragma unroll
                for (int i = 0; i < 8; ++i) t[i] = a[i] + gv[i] * v[i]; }
            *(u32x4*)mp = pack8(t);
        EPI_LOOP_END
    }
};
struct EpiRes {
    const float* xl; const float* gmod; float* Y; int lgL, b0, isctx;
    DEVI void operator()(AccRef acc, const pg8::Unit& u, int wr, int wc, int fr, int fq) const {
        EPI_LOOP_BEGIN
            const int mi = isctx ? 8 : b0 + (r >> lgL);
            const float* gp = gmod + (size_t)mi * 6144 + c; const float* xp = xl + (size_t)r * DM + c; float* yp = Y + (size_t)r * DM + c;
            const f32x4 g0 = *(const f32x4*)gp, g1 = *(const f32x4*)(gp + 4), x0 = *(const f32x4*)xp, x1 = *(const f32x4*)(xp + 4);
            *(f32x4*)yp = (f32x4){DN_ALPHA * x0[0] + g0[0] * v[0], DN_ALPHA * x0[1] + g0[1] * v[1], DN_ALPHA * x0[2] + g0[2] * v[2], DN_ALPHA * x0[3] + g0[3] * v[3]};
            *(f32x4*)(yp + 4) = (f32x4){DN_ALPHA * x1[0] + g1[0] * v[4], DN_ALPHA * x1[1] + g1[1] * v[5], DN_ALPHA * x1[2] + g1[2] * v[6], DN_ALPHA * x1[3] + g1[3] * v[7]};
        EPI_LOOP_END
    }
};
struct EpiF1 {
    bf16_t* G;
    DEVI void operator()(AccRef acc, const pg8::Unit& u, int wr, int wc, int fr, int fq) const {
        EPI_LOOP_BEGIN
            float o[4];
#pragma unroll
            for (int i = 0; i < 4; ++i) o[i] = v[i] * sigmoidf_(v[i]) * v[4 + i];
            u32x2 w; w.x = cvt_pk_bf16(o[0], o[1]); w.y = cvt_pk_bf16(o[2], o[3]);
            *(u32x2*)(G + (size_t)r * DFF + (c >> 1)) = w;
        EPI_LOOP_END
    }
};

namespace att {
constexpr int D = 128, NW = 8, QBLK = 32, KVBLK = 64;
constexpr float SCALE = 0.088388347648318440f;
constexpr float THR = 8.f;
constexpr size_t SHM_V = KVBLK * D * 2, SHM_K = KVBLK * D * 2, SHM_ATTN = 2 * SHM_V + 2 * SHM_K + NW * 64 * 4;
#define KSWZ(row, colB) ((row) * 256 + ((colB) ^ (((row) & 7) << 4)))
#define SBAR() __builtin_amdgcn_sched_barrier(0)
DEVI int crow(int r, int hi) { return (r & 3) + 8 * (r >> 2) + 4 * hi; }
DEVI void partialSM(f32x16& p0, f32x16& p1, float mnC) {
  if (mnC != 0.f) { for (int r = 0; r < 16; ++r) p0[r] += mnC; for (int r = 0; r < 16; ++r) p1[r] += mnC; }
  for (int r = 0; r < 16; ++r) p0[r] = __builtin_amdgcn_exp2f(p0[r]);
}
DEVI void finishSM(f32x16& p0, f32x16& p1, float& l_reg, bf16x8& pa0, bf16x8& pa1, bf16x8& pa2, bf16x8& pa3) {
  for (int r = 0; r < 16; ++r) p1[r] = __builtin_amdgcn_exp2f(p1[r]);
  float ps = 0; for (int r = 0; r < 16; ++r) ps += p0[r]; for (int r = 0; r < 16; ++r) ps += p1[r];
  { auto rr = __builtin_amdgcn_permlane32_swap(__float_as_uint(ps), __float_as_uint(ps), false, false);
    ps = __uint_as_float(rr[0]) + __uint_as_float(rr[1]); }
  l_reg += ps;
#define PK4(P, BASE, OUT) do { unsigned a0 = cvt_pk_bf16(P[BASE + 0], P[BASE + 1]), a1 = cvt_pk_bf16(P[BASE + 2], P[BASE + 3]);   \
    unsigned b0 = cvt_pk_bf16(P[BASE + 4], P[BASE + 5]), b1 = cvt_pk_bf16(P[BASE + 6], P[BASE + 7]);                              \
    auto r0 = __builtin_amdgcn_permlane32_swap(a0, b0, false, false); auto r1 = __builtin_amdgcn_permlane32_swap(a1, b1, false, false); \
    u32x4 w = {r0[0], r1[0], r0[1], r1[1]}; OUT = *reinterpret_cast<bf16x8*>(&w); } while (0)
  PK4(p0, 0, pa0); PK4(p0, 8, pa1); PK4(p1, 0, pa2); PK4(p1, 8, pa3);
#undef PK4
}
DEVI void qkt(f32x16& p0, f32x16& p1, const bf16_t* Ks, const bf16x8* qr, int r32, int hi) {
  p0 = f32x16{}; p1 = f32x16{};
  for (int d0 = 0; d0 < 8; ++d0) { int cb = (d0 * 16 + hi * 8) * 2;
    bf16x8 b0 = *reinterpret_cast<const bf16x8*>((const char*)Ks + KSWZ(r32, cb));
    bf16x8 b1 = *reinterpret_cast<const bf16x8*>((const char*)Ks + KSWZ(32 + r32, cb));
    p0 = __builtin_amdgcn_mfma_f32_32x32x16_bf16(b0, qr[d0], p0, 0, 0, 0);
    p1 = __builtin_amdgcn_mfma_f32_32x32x16_bf16(b1, qr[d0], p1, 0, 0, 0); }
}
DEVI int v_st(int k, int c) { const int kk = (k & ~0xC) | ((k & 4) << 1) | ((k & 8) >> 1); return ((kk >> 3) * 4 + (c >> 5)) * 512 + ((kk & 7) * 32 + (c & 31)) * 2; }
DEVI int v_rd_base(int lane) { return ((lane & 3) << 3) | (((lane >> 2) & 3) << 6) | (((lane >> 4) & 1) << 5) | (((lane >> 5) & 1) << 8); }
constexpr int v_rd_off(int d0, int ks, int half) { return d0 * 512 + ks * 4096 + half * 2048; }
template <int OFF> DEVI s16x4 tr_read(int vb) {
  s16x4 r; asm volatile("ds_read_b64_tr_b16 %0, %1 offset:%2" : "=&v"(r) : "v"(vb), "i"(OFF) : "memory"); return r;
}
template <int D0> DEVI void pv_one(f32x16& od, int vb, bf16x8 pa0, bf16x8 pa1, bf16x8 pa2, bf16x8 pa3) {
  const s16x4 l0 = tr_read<v_rd_off(D0, 0, 0)>(vb), h0 = tr_read<v_rd_off(D0, 0, 1)>(vb), l1 = tr_read<v_rd_off(D0, 1, 0)>(vb), h1 = tr_read<v_rd_off(D0, 1, 1)>(vb);
  const s16x4 l2 = tr_read<v_rd_off(D0, 2, 0)>(vb), h2 = tr_read<v_rd_off(D0, 2, 1)>(vb), l3 = tr_read<v_rd_off(D0, 3, 0)>(vb), h3 = tr_read<v_rd_off(D0, 3, 1)>(vb);
  asm volatile("s_waitcnt lgkmcnt(0)" ::: "memory"); SBAR();
#define PK(L, H) (bf16x8){L[0], L[1], L[2], L[3], H[0], H[1], H[2], H[3]}
  od = __builtin_amdgcn_mfma_f32_32x32x16_bf16(pa0, PK(l0, h0), od, 0, 0, 0);
  od = __builtin_amdgcn_mfma_f32_32x32x16_bf16(pa1, PK(l1, h1), od, 0, 0, 0);
  od = __builtin_amdgcn_mfma_f32_32x32x16_bf16(pa2, PK(l2, h2), od, 0, 0, 0);
  od = __builtin_amdgcn_mfma_f32_32x32x16_bf16(pa3, PK(l3, h3), od, 0, 0, 0);
#undef PK
}
DEVI void pv_d0(f32x16* o, int vb, bf16x8 pa0, bf16x8 pa1, bf16x8 pa2, bf16x8 pa3) {
  pv_one<0>(o[0], vb, pa0, pa1, pa2, pa3); pv_one<1>(o[1], vb, pa0, pa1, pa2, pa3); pv_one<2>(o[2], vb, pa0, pa1, pa2, pa3); pv_one<3>(o[3], vb, pa0, pa1, pa2, pa3);
}
DEVI void attn_dense_body(const bf16_t* Qb, const bf16_t* Kh, const bf16_t* Vh, bf16_t* Ob, int seq, int ldq, int ldk, int ldo, float mshift, char* lds) {
  const int tid = opq_v(threadIdx.x), wid = tid >> 6, lane = tid & 63, r32 = lane & 31, hi = lane >> 5;
  bf16_t* V_lds = (bf16_t*)lds; bf16_t* K_lds = (bf16_t*)(lds + 2 * SHM_V);
  float* ws = (float*)(lds + 2 * SHM_V + 2 * SHM_K) + wid * 64; float* li_l = ws;
  const float mnC = (mshift * 1.4426950408889634f > 60.f) ? -mshift * 1.4426950408889634f : 0.f; float l_reg = 0; f32x16 o[4] = {}; bf16x8 qr[8];
  const bf16_t* Qw = Qb + (long)(wid * QBLK + r32) * ldq + hi * 8;
#pragma unroll
  for (int d0 = 0; d0 < 8; ++d0) qr[d0] = *reinterpret_cast<const bf16x8*>(Qw + d0 * 16);
  const int sr = tid >> 4, sc = (tid & 15) * 8, vst0 = v_st(sr, sc), vst1 = v_st(32 + sr, sc);
  const int vb0 = (int)(uintptr_t)V_lds + v_rd_base(lane);
  struct { bf16x8 vs0, vs1, ks0, ks1; } sr_[2];
  const unsigned goff0 = (unsigned)(sr * ldk + sc) * 2u, goff1 = (unsigned)((32 + sr) * ldk + sc) * 2u;
#define SLOAD(i, k0) do { const char* vbp_ = (const char*)Vh + (size_t)(k0) * ldk * 2; const char* kbp_ = (const char*)Kh + (size_t)(k0) * ldk * 2; \
    sr_[i].vs0 = *reinterpret_cast<const bf16x8*>(vbp_ + goff0); sr_[i].vs1 = *reinterpret_cast<const bf16x8*>(vbp_ + goff1); \
    sr_[i].ks0 = *reinterpret_cast<const bf16x8*>(kbp_ + goff0); sr_[i].ks1 = *reinterpret_cast<const bf16x8*>(kbp_ + goff1); } while (0)
#define SWRITE(b, i) do { *(bf16x8*)((char*)V_lds + (b) * SHM_V + vst0) = sr_[i].vs0;          \
    *(bf16x8*)((char*)V_lds + (b) * SHM_V + vst1) = sr_[i].vs1; int kc = sc * 2;               \
    *(bf16x8*)((char*)K_lds + (b) * SHM_K + KSWZ(sr, kc)) = sr_[i].ks0;                       \
    *(bf16x8*)((char*)K_lds + (b) * SHM_K + KSWZ(32 + sr, kc)) = sr_[i].ks1; } while (0)
#define SWAIT() do { asm volatile("s_waitcnt vmcnt(4)" ::: "memory"); } while (0)
  f32x16 pA0, pA1, pB0, pB1; bf16x8 pa0, pa1, pa2, pa3; const int NT = seq / KVBLK;
  constexpr int SE = 0, SO = 1;
  SLOAD(SE, 0); asm volatile("s_waitcnt vmcnt(0)" ::: "memory"); SWRITE(0, SE); __syncthreads();
  qkt(pA0, pA1, K_lds, qr, r32, hi); partialSM(pA0, pA1, mnC);
  SLOAD(SO, KVBLK); if (2 < NT) SLOAD(SE, 2 * KVBLK);
  SWAIT(); SWRITE(1, SO); __syncthreads();
  for (int j = 1; j + 1 < NT; j += 2) {
    SBAR(); qkt(pB0, pB1, (bf16_t*)((char*)K_lds + SHM_K), qr, r32, hi);
    finishSM(pA0, pA1, l_reg, pa0, pa1, pa2, pa3); SBAR();
    SLOAD(SO, (j + 2) * KVBLK); SBAR();
    pv_d0(o, vb0, pa0, pa1, pa2, pa3); partialSM(pB0, pB1, mnC);
    __syncthreads(); SWAIT(); SWRITE(0, SE);
    __syncthreads();
    SBAR(); qkt(pA0, pA1, K_lds, qr, r32, hi);
    finishSM(pB0, pB1, l_reg, pa0, pa1, pa2, pa3); SBAR();
    if (j + 3 < NT) SLOAD(SE, (j + 3) * KVBLK); SBAR();
    pv_d0(o, vb0 + (int)SHM_V, pa0, pa1, pa2, pa3); partialSM(pA0, pA1, mnC);
    __syncthreads(); SWAIT(); SWRITE(1, SO);
    __syncthreads();
  }
  SBAR(); qkt(pB0, pB1, (bf16_t*)((char*)K_lds + SHM_K), qr, r32, hi);
  finishSM(pA0, pA1, l_reg, pa0, pa1, pa2, pa3); SBAR();
  pv_d0(o, vb0, pa0, pa1, pa2, pa3); partialSM(pB0, pB1, mnC);
  __syncthreads();
  finishSM(pB0, pB1, l_reg, pa0, pa1, pa2, pa3); SBAR();
  pv_d0(o, vb0 + (int)SHM_V, pa0, pa1, pa2, pa3);
  if (hi == 0) li_l[r32] = l_reg; asm volatile("s_waitcnt lgkmcnt(0)" ::: "memory");
  float rli[16];
#pragma unroll
  for (int r = 0; r < 16; ++r) rli[r] = __builtin_amdgcn_rcpf(li_l[crow(r, hi)]);
  bf16_t* Ow = Ob + (long)(wid * QBLK) * ldo;
#pragma unroll
  for (int r = 0; r < 16; ++r) { int orow = crow(r, hi);
#pragma unroll
    for (int d0 = 0; d0 < 4; ++d0) Ow[(long)orow * ldo + d0 * 32 + r32] = (bf16_t)(cvt_pk_bf16(o[d0][r] * rli[r], 0.f) & 0xffffu); }
  __syncthreads();
#undef SLOAD
#undef SWRITE
#undef SWAIT
}
}

DEVI float2 cmul(float2 a, float2 b) { return make_float2(a.x * b.x - a.y * b.y, a.x * b.y + a.y * b.x); }
DEVI float2 cmulc(float2 a, float2 b) { return make_float2(a.x * b.x + a.y * b.y, a.y * b.x - a.x * b.y); }
DEVI float2 cadd(float2 a, float2 b) { return make_float2(a.x + b.x, a.y + b.y); }
DEVI float2 csub(float2 a, float2 b) { return make_float2(a.x - b.x, a.y - b.y); }
DEVI void fft_tables(float2* tab) {
    const int tid = opq_v(threadIdx.x);
    if (tid < 128) { const int k = tid < 64 ? tid : (tid - 64) * 64; float s, c; sincospif(-(float)k / 8192.f, &s, &c); tab[tid] = make_float2(c, s); }
}
DEVI int sw(int i) { return i ^ ((i >> 5) & 1) ^ (((i >> 6) & 1) * 6) ^ (((i >> 7) & 3) << 3); }
DEVI float2 twid(const float2* tab, int k) { return cmul(tab[k & 63], tab[64 + (k >> 6)]); }
template <int LQ> DEVI void fft_fwd_pass(float2* X, const float2* tab) {
    constexpr int q = 1 << LQ; const int tid = opq_v(threadIdx.x);
#pragma unroll 2
    for (int i = 0; i < 8; ++i) {
        const int g = tid + NTHR * i; const int j = g & (q - 1); const int base = ((g >> LQ) << (LQ + 2)) + j;
        const int a0 = sw(base), a1 = sw(base + q), a2 = sw(base + 2 * q), a3 = sw(base + 3 * q);
        const float2 e0 = X[a0], e1 = X[a1], e2 = X[a2], e3 = X[a3];
        const float2 w1 = twid(tab, j << (12 - LQ)), w2 = cmul(w1, w1);
        const float2 f0 = cadd(e0, e2), f2 = cmul(csub(e0, e2), w1), f1 = cadd(e1, e3), d13 = csub(e1, e3);
        const float2 f3 = cmul(make_float2(d13.y, -d13.x), w1);
        X[a0] = cadd(f0, f1); X[a1] = cmul(csub(f0, f1), w2); X[a2] = cadd(f2, f3); X[a3] = cmul(csub(f2, f3), w2);
    }
    __syncthreads();
}
template <int LQ> DEVI void fft_inv_pass(float2* X, const float2* tab) {
    constexpr int q = 1 << LQ; const int tid = opq_v(threadIdx.x);
#pragma unroll 2
    for (int i = 0; i < 8; ++i) {
        const int g = tid + NTHR * i; const int j = g & (q - 1); const int base = ((g >> LQ) << (LQ + 2)) + j;
        const int a0 = sw(base), a1 = sw(base + q), a2 = sw(base + 2 * q), a3 = sw(base + 3 * q);
        const float2 g0 = X[a0], g1 = X[a1], g2 = X[a2], g3 = X[a3];
        const float2 w1 = twid(tab, j << (12 - LQ)), w2 = cmul(w1, w1);
        const float2 t = cmulc(g1, w2), f0 = cadd(g0, t), f1 = csub(g0, t), t2 = cmulc(g3, w2), f2 = cadd(g2, t2), f3 = csub(g2, t2);
        const float2 uu = cmulc(f2, w1), vv = cmulc(f3, w1), u2 = make_float2(-vv.y, vv.x);
        X[a0] = cadd(f0, uu); X[a2] = csub(f0, uu); X[a1] = cadd(f1, u2); X[a3] = csub(f1, u2);
    }
    __syncthreads();
}
DEVI void r4f(float2& e0, float2& e1, float2& e2, float2& e3, float2 w1, float2 w2) {
    const float2 f0 = cadd(e0, e2), f2 = cmul(csub(e0, e2), w1), f1 = cadd(e1, e3), d13 = csub(e1, e3);
    const float2 f3 = cmul(make_float2(d13.y, -d13.x), w1);
    e0 = cadd(f0, f1); e1 = cmul(csub(f0, f1), w2); e2 = cadd(f2, f3); e3 = cmul(csub(f2, f3), w2);
}
DEVI void r4i(float2& g0, float2& g1, float2& g2, float2& g3, float2 w1, float2 w2) {
    const float2 t = cmulc(g1, w2), f0 = cadd(g0, t), f1 = csub(g0, t), t2 = cmulc(g3, w2), f2 = cadd(g2, t2), f3 = csub(g2, t2);
    const float2 uu = cmulc(f2, w1), vv = cmulc(f3, w1), u2 = make_float2(-vv.y, vv.x);
    g0 = cadd(f0, uu); g2 = csub(f0, uu); g1 = cadd(f1, u2); g3 = csub(f1, u2);
}
template <int LQ> DEVI int r16_sb(int base) {
    if (LQ == 10) return sw(base);
    if (LQ == 6) return base ^ ((base >> 5) & 1);
    return base ^ ((((base >> 6) & 1) * 6) ^ (((base >> 7) & 3) << 3));
}
template <int LQ> DEVI int r16_addr(int sb, int e) {
    if (LQ == 10) return sb + e * 1024;
    if (LQ == 6) return (sb ^ (((e & 1) * 6) ^ (((e >> 1) & 3) << 3))) + 64 * e;
    return sb ^ ((4 * e) ^ (e >> 3));
}
template <int LQ, bool INV, int HALF = 0> DEVI void fft_r16_pass(float2* X, const float2* tab) {
    constexpr int q = 1 << LQ; const int tid = opq_v(threadIdx.x);
#pragma unroll 1
    for (int i = 0; i < 2; ++i) {
        const int g = tid + NTHR * i; const int j = g & (q - 1); const int base = ((g >> LQ) << (LQ + 4)) + j;
        float2 x[16]; const int sb = r16_sb<LQ>(base);
#pragma unroll
        for (int e = 0; e < 16; ++e) x[e] = (HALF == 1 && e >= 8) ? make_float2(0.f, 0.f) : X[r16_addr<LQ>(sb, e)];
        const float2 wb = twid(tab, j << (10 - LQ));
        float2 w[4]; w[0] = wb; w[1] = cmul(wb, make_float2(0.92387953251128674f, -0.38268343236508977f)); w[2] = cmul(wb, make_float2(0.70710678118654752f, -0.70710678118654752f));
        w[3] = cmul(wb, make_float2(0.38268343236508977f, -0.92387953251128674f));
        const float2 wb2 = cmul(wb, wb), w4 = cmul(wb2, wb2), w8 = cmul(w4, w4);
        if (!INV) {
#pragma unroll
            for (int e = 0; e < 4; ++e) r4f(x[e], x[e + 4], x[e + 8], x[e + 12], w[e], cmul(w[e], w[e]));
#pragma unroll
            for (int m = 0; m < 4; ++m) r4f(x[4 * m], x[4 * m + 1], x[4 * m + 2], x[4 * m + 3], w4, w8);
        } else {
#pragma unroll
            for (int m = 0; m < 4; ++m) r4i(x[4 * m], x[4 * m + 1], x[4 * m + 2], x[4 * m + 3], w4, w8);
#pragma unroll
            for (int e = 0; e < 4; ++e) r4i(x[e], x[e + 4], x[e + 8], x[e + 12], w[e], cmul(w[e], w[e]));
        }
#pragma unroll
        for (int e = 0; e < 16; ++e) if (!(HALF == 2 && e >= 8)) X[r16_addr<LQ>(sb, e)] = x[e];
    }
    __syncthreads();
}
DEVI void fft_mid_mul(float2* X, const float2* kfc) {
    const int tid = opq_v(threadIdx.x);
#pragma unroll 1
    for (int ib = 0; ib < 8; ib += 4) {
        f32x4 k01[4], k23[4];
#pragma unroll
        for (int u = 0; u < 4; ++u) { const int base = (tid + NTHR * (ib + u)) * 4; k01[u] = *(const f32x4*)(kfc + base); k23[u] = *(const f32x4*)(kfc + base + 2); }
#pragma unroll
        for (int u = 0; u < 4; ++u) {
            const int base = (tid + NTHR * (ib + u)) * 4;
            const int a0 = sw(base), a1 = sw(base + 1), a2 = sw(base + 2), a3 = sw(base + 3);
            const float2 e0 = X[a0], e1 = X[a1], e2 = X[a2], e3 = X[a3];
            const float2 f0 = cadd(e0, e2), f2 = csub(e0, e2), f1 = cadd(e1, e3), d13 = csub(e1, e3), f3 = make_float2(d13.y, -d13.x);
            const float2 g0 = cmul(cadd(f0, f1), make_float2(k01[u][0], k01[u][1])), g1 = cmul(csub(f0, f1), make_float2(k01[u][2], k01[u][3]));
            const float2 g2 = cmul(cadd(f2, f3), make_float2(k23[u][0], k23[u][1])), g3 = cmul(csub(f2, f3), make_float2(k23[u][2], k23[u][3]));
            const float2 h0 = cadd(g0, g1), h1 = csub(g0, g1), h2 = cadd(g2, g3), h3 = csub(g2, g3), u2 = make_float2(-h3.y, h3.x);
            X[a0] = cadd(h0, h2); X[a2] = csub(h0, h2); X[a1] = cadd(h1, u2); X[a3] = csub(h1, u2);
        }
    }
    __syncthreads();
}
DEVI void fft_fwd(float2* X, const float2* tab) { fft_r16_pass<10, false>(X, tab); fft_r16_pass<6, false>(X, tab); fft_r16_pass<2, false>(X, tab); fft_fwd_pass<0>(X, tab); }
DEVI void fft_inv(float2* X, const float2* tab) { fft_inv_pass<0>(X, tab); fft_r16_pass<2, true>(X, tab); fft_r16_pass<6, true>(X, tab); fft_r16_pass<10, true>(X, tab); }

DEVI float block_sum(float v, float* red) {
    v = wave_sum(v); const int tid = opq_v(threadIdx.x);
    __syncthreads();
    if ((tid & 63) == 0) red[tid >> 6] = v;
    __syncthreads();
    float s = 0.f;
#pragma unroll
    for (int i = 0; i < 8; ++i) s += red[i];
    return s;
}

template <int MAP> DEVI void wt_transpose(const float* src, int K, int N, bf16_t* dst, float* lds, int bid, int nb) {
    const int tid = opq_v(threadIdx.x), ntn = N / 256, ntiles = (K / 64) * ntn;
    for (int tile = bid; tile < ntiles; tile += nb) {
        const int k0 = (tile / ntn) * 64, n0 = (tile % ntn) * 256;
        __syncthreads();
        f32x4 v[8];
#pragma unroll
        for (int ps = 0; ps < 8; ++ps) v[ps] = *(const f32x4*)(src + (size_t)(k0 + (tid >> 6) + 8 * ps) * N + n0 + (tid & 63) * 4);
#pragma unroll
        for (int ps = 0; ps < 8; ++ps) { const int kk = (tid >> 6) + 8 * ps, nn = (tid & 63) * 4;
            lds[kk * 257 + nn] = v[ps][0]; lds[kk * 257 + nn + 1] = v[ps][1]; lds[kk * 257 + nn + 2] = v[ps][2]; lds[kk * 257 + nn + 3] = v[ps][3]; }
        __syncthreads();
#pragma unroll
        for (int ps = 0; ps < 4; ++ps) { const int nn = (tid >> 3) + 64 * ps, k8 = (tid & 7) * 8; float o[8];
#pragma unroll
            for (int i = 0; i < 8; ++i) o[i] = lds[(k8 + i) * 257 + nn];
            const int n = n0 + nn; const int nd = MAP == 0 ? n : (8 * (n >> 2) + (n & 3) + (MAP == 2 ? 4 : 0));
            *(u32x4*)(dst + (size_t)nd * K + k0 + k8) = pack8(o); }
    }
}
DEVI void wpc_job(const float* pool_w, const float* pool_s, const float* wb2, bf16_t* dst, float* lds, int bid, int nb) {
    const int tid = opq_v(threadIdx.x);
    float* sa = lds;
    float* sb = lds + 64 * 257;
    for (int tile = bid; tile < 256; tile += nb) {
        const int g = tile >> 6, c0 = ((tile >> 4) & 3) * 64, e0 = (tile & 15) * 64;
        __syncthreads();
        for (int idx = tid; idx < 64 * 256; idx += NTHR) { const int cc = idx >> 8, d = idx & 255; sa[cc * 257 + d] = pool_w[((size_t)g * 256 + c0 + cc) * 256 + d]; }
        for (int idx = tid; idx < 256 * 64; idx += NTHR) { const int d = idx >> 6, ee = idx & 63; sb[d * 65 + ee] = pool_s[g * 256 + d] * wb2[(size_t)(g * 256 + d) * DM + e0 + ee]; }
        __syncthreads();
        const int ee = tid >> 3, c8 = (tid & 7) * 8; float acc[8];
#pragma unroll
        for (int i = 0; i < 8; ++i) acc[i] = 0.f;
        for (int d = 0; d < 256; ++d) { const float b = sb[d * 65 + ee];
#pragma unroll
            for (int i = 0; i < 8; ++i) acc[i] += sa[(c8 + i) * 257 + d] * b; }
        *(u32x4*)(dst + (size_t)(e0 + ee) * DM + g * 256 + c0 + c8) = pack8(acc);
    }
}
DEVI void modp_job(const Params& p, float* modp, float* lds, int bid, int nb) {
    const int tid = opq_v(threadIdx.x);
    for (int unit = bid; unit < 2 * 16 * 12; unit += nb) {
        const int l = unit / 192, ks = (unit / 12) % 16, jb = unit % 12, j = jb * 512 + tid;
        __syncthreads();
        for (int idx = tid; idx < 9 * 64; idx += NTHR) { const int m = idx >> 6, kk = idx & 63; const float cv = m < 8 ? p.in[I_C][m * DM + ks * 64 + kk] : p.in[I_CCTX][ks * 64 + kk];
            lds[idx] = cv * sigmoidf_(cv); }
        __syncthreads();
        float acc[9];
#pragma unroll
        for (int m = 0; m < 9; ++m) acc[m] = 0.f;
        const float* w = p.in[I_WADA] + ((size_t)l * DM + ks * 64) * 6144 + j;
        for (int kk = 0; kk < 64; ++kk) { const float wv = w[(size_t)kk * 6144];
#pragma unroll
            for (int m = 0; m < 9; ++m) acc[m] += lds[m * 64 + kk] * wv; }
#pragma unroll
        for (int m = 0; m < 9; ++m) modp[(((size_t)l * 16 + ks) * 9 + m) * 6144 + j] = acc[m];
    }
}
DEVI void gen_filter(const Params& p, int l, int L, int mode, float* dst, float* lds, int bid, int nb) {
    const int tid = opq_v(threadIdx.x);
    float* feats = lds;
    float* h1 = lds + 32 * 33;
    float* h2 = h1 + 32 * 64;
    const float* w1 = p.in[I_HW1] + (size_t)l * 33 * 64; const float* b1 = p.in[I_HB1] + l * 64; const float* fq = p.in[I_HFREQ] + l * 64;
    const float* w2 = p.in[I_HW2] + (size_t)l * 64 * 64; const float* b2 = p.in[I_HB2] + l * 64; const float* w3 = p.in[I_HW3] + (size_t)l * 64 * 2048;
    const float inv_lm1 = 1.f / (float)(L - 1);
    for (int unit = bid; unit < L / 32; unit += nb) {
        const int t0 = unit * 32;
        __syncthreads();
        for (int idx = tid; idx < 32 * 33; idx += NTHR) { const int tt = idx / 33, f = idx % 33; const float tf = (float)(t0 + tt); float v;
            if (f == 0) v = tf * inv_lm1;
            else { const int bi = (f - 1) & 15; const float band = 1e-4f + (float)bi * ((15.f - 1e-4f) / 15.f); const float ang = (6.283185307179586f / (float)L) * tf * band; v = f <= 16 ? cosf(ang) : -sinf(ang); }
            feats[idx] = v; }
        __syncthreads();
#pragma unroll 1
        for (int k = 0; k < 4; ++k) { const int idx = tid + NTHR * k, tt = idx >> 6, j = idx & 63; float a = b1[j];
#pragma unroll 3
            for (int f = 0; f < 33; ++f) a += feats[tt * 33 + f] * w1[f * 64 + j];
            h1[idx] = sinf(fq[j] * a); }
        __syncthreads();
#pragma unroll 1
        for (int k = 0; k < 4; ++k) { const int idx = tid + NTHR * k, tt = idx >> 6, j = idx & 63; float a = b2[j];
#pragma unroll 8
            for (int i = 0; i < 64; ++i) a += h1[tt * 64 + i] * w2[i * 64 + j];
            h2[idx] = sinf(fq[j] * a); }
        __syncthreads();
        { const int wid = tid >> 6, lane = tid & 63, m = lane & 31, hi = lane >> 5;
          bf16x8 af[4];
#pragma unroll
          for (int kk = 0; kk < 4; ++kk) { float hv[8];
#pragma unroll
              for (int j = 0; j < 8; ++j) hv[j] = h2[m * 64 + 16 * kk + hi * 8 + j];
              const u32x4 pk = pack8(hv); af[kk] = *reinterpret_cast<const bf16x8*>(&pk); }
          const float dmin = -3.0701134573253946f, dmax = -15.350567286626973f;
#pragma unroll 1
          for (int tl = wid; tl < 64; tl += 8) {
              const int o = tl * 32 + m, isb = tl >> 5;
              f32x16 acc = {};
#pragma unroll
              for (int kk = 0; kk < 4; ++kk) { float wv[8];
#pragma unroll
                  for (int j = 0; j < 8; ++j) wv[j] = w3[(size_t)(16 * kk + hi * 8 + j) * 2048 + o];
                  const u32x4 pk = pack8(wv);
                  acc = __builtin_amdgcn_mfma_f32_32x32x16_bf16(*reinterpret_cast<const bf16x8*>(&pk), af[kk], acc, 0, 0, 0); }
              const int t = t0 + m; const float t01 = (float)t * inv_lm1;
#pragma unroll
              for (int r = 0; r < 16; ++r) { const int c = (tl * 32 + (r & 3) + 8 * (r >> 2) + 4 * hi) & 1023;
                  const float delta = fabsf(dmin + (float)c * ((dmax - dmin) / 1023.f)); const float val = acc[r] * (__expf(-t01 * delta) + 0.05f);
                  if (mode == 0) { if (!isb) dst[(size_t)c * FFTN + t] = val; else if (t > 0) dst[(size_t)c * FFTN + FFTN - t] = val; else dst[(size_t)c * FFTN + SEQ] = 0.f; }
                  else { if (!isb) dst[c * 512 + 256 + t] = val; else if (t > 0) dst[c * 512 + 256 - t] = val; else dst[c * 512] = 0.f; }
              }
          }
        }
    }
}
DEVI void kf_job(const float* kt, const float* hyd, float2* kf, char* ldsc, int bid, int nb) {
    const int tid = opq_v(threadIdx.x); float2* X = (float2*)ldsc; float2* tab = (float2*)(ldsc + FFTN * 8); float* red = (float*)(tab + 128);
    __syncthreads(); fft_tables(tab); __syncthreads();
    for (int u = bid; u < 512; u += nb) {
        const int c0 = 2 * u, c1 = c0 + 1;
        float ss0 = 0.f, ss1 = 0.f;
#pragma unroll 2
        for (int i = 0; i < 8; ++i) { const int t4 = (tid + NTHR * i) * 4; const f32x4 va = *(const f32x4*)(kt + (size_t)c0 * FFTN + t4), vb = *(const f32x4*)(kt + (size_t)c1 * FFTN + t4);
            ss0 += va[0] * va[0] + va[1] * va[1] + va[2] * va[2] + va[3] * va[3]; ss1 += vb[0] * vb[0] + vb[1] * vb[1] + vb[2] * vb[2] + vb[3] * vb[3];
            X[sw(t4)] = make_float2(va[0], vb[0]); X[sw(t4 + 1)] = make_float2(va[1], vb[1]); X[sw(t4 + 2)] = make_float2(va[2], vb[2]); X[sw(t4 + 3)] = make_float2(va[3], vb[3]); }
        const float tot0 = block_sum(ss0, red); const float tot1 = block_sum(ss1, red);
        const float sc0 = 0.5f * rsqrtf(tot0 + EPSF) * (1.f / FFTN), sc1 = 0.5f * rsqrtf(tot1 + EPSF) * (1.f / FFTN); const float dd0 = hyd[c0] * (1.f / FFTN), dd1 = hyd[c1] * (1.f / FFTN);
        fft_fwd(X, tab);
#pragma unroll 4
        for (int i = 0; i < 32; ++i) { const int pp = tid + NTHR * i; const int k = (int)(__brev((unsigned)pp) >> 18); const int pq = (int)(__brev((unsigned)((FFTN - k) & (FFTN - 1))) >> 18);
            const float2 xp = X[sw(pp)], xq = X[sw(pq)];
            kf[(size_t)c0 * FFTN + pp] = make_float2((xp.x + xq.x) * sc0 + dd0, (xp.y - xq.y) * sc0);
            kf[(size_t)c1 * FFTN + pp] = make_float2((xp.y + xq.y) * sc1 + dd1, (xq.x - xp.x) * sc1); }
        __syncthreads();
    }
}
DEVI void fftconv_job(const bf16_t* zt, bf16_t* zo, const float2* kf, char* ldsc, int bid, int nb) {
    const int tid = opq_v(threadIdx.x); float2* X = (float2*)ldsc; float2* tab = (float2*)(ldsc + FFTN * 8);
    __syncthreads(); fft_tables(tab); __syncthreads();
    for (int c = bid; c < 1024; c += nb) {
        const bf16_t* z0 = zt + (size_t)c * SEQ; const bf16_t* z1 = zt + (size_t)(1024 + c) * SEQ;
#pragma unroll
        for (int i = 0; i < 2; ++i) { const int t8 = (tid + NTHR * i) * 8; float a[8], b[8]; ld8bf(z0 + t8, a); ld8bf(z1 + t8, b);
#pragma unroll
            for (int e = 0; e < 8; ++e) X[sw(t8 + e)] = make_float2(a[e], b[e]); }
        __syncthreads();
        fft_r16_pass<10, false, 1>(X, tab); fft_r16_pass<6, false>(X, tab); fft_r16_pass<2, false>(X, tab);
        fft_mid_mul(X, kf + (size_t)c * FFTN);
        fft_r16_pass<2, true>(X, tab); fft_r16_pass<6, true>(X, tab); fft_r16_pass<10, true, 2>(X, tab);
#pragma unroll
        for (int i = 0; i < 2; ++i) { const int t8 = (tid + NTHR * i) * 8; float a[8], b[8];
#pragma unroll
            for (int e = 0; e < 8; ++e) { const float2 v = X[sw(t8 + e)]; a[e] = v.x; b[e] = v.y; }
            *(u32x4*)(zo + (size_t)c * SEQ + t8) = pack8(a); *(u32x4*)(zo + (size_t)(1024 + c) * SEQ + t8) = pack8(b); }
        __syncthreads();
    }
}
DEVI void ctxconv_job(bf16_t* zt, const float* kc, const float* hyd, float* lds, int bid, int nb) {
    const int tid = opq_v(threadIdx.x); float* zs = lds; float* ks = lds + 256; float* red = lds + 768;
    for (int unit = bid; unit < NBATCH * 1024; unit += nb) {
        const int c = unit & 1023; bf16_t* z = zt + (size_t)unit * 256;
        __syncthreads();
        const float kv = kc[c * 512 + tid]; ks[tid] = kv; if (tid < 256) zs[tid] = bf2f(z[tid]);
        const float tot = block_sum(kv * kv, red);
        const float nrm = rsqrtf(tot + EPSF);
        if (tid < 256) { float a = 0.f;
            for (int s = 0; s < 256; ++s) a += ks[256 + tid - s] * zs[s];
            z[tid] = (bf16_t)(cvt_pk_bf16(a * nrm + hyd[c] * zs[tid], 0.f) & 0xffffu); }
    }
    __syncthreads();
}

DEVI void headfix_one(const Params& p, const Chunk& ch, int l, u32x4 raw, int r, int hh, int li, bf16_t* P, bf16_t* kall, const float2* rope) {
    float x[8]; unpack8(raw, x);
    float ss = 0.f;
#pragma unroll
    for (int i = 0; i < 8; ++i) ss += x[i] * x[i];
    ss += __shfl_xor(ss, 1); ss += __shfl_xor(ss, 2); ss += __shfl_xor(ss, 4); ss += __shfl_xor(ss, 8);
    const float rstd = rsqrtf(ss * (1.f / 128.f) + EPSF);
    const float* gw = (hh < 8 ? p.in[I_QG] : p.in[I_KG]) + l * 128 + li * 8;
    float y[8];
#pragma unroll
    for (int i = 0; i < 8; ++i) y[i] = x[i] * rstd * gw[i];
    if (!ch.isctx) {
        const int t = r & (SEQ - 1); const int pos = (li < 8) ? (t >> 6) : (t & 63); const int f0 = 8 * (li & 3);
#pragma unroll
        for (int i = 0; i < 8; ++i) { const float yp = __shfl_xor(y[i], 4); const float2 cs = rope[pos * 32 + f0 + i];
            y[i] = (li & 4) ? (y[i] * cs.x + yp * cs.y) : (y[i] * cs.x - yp * cs.y); }
    }
    if (hh < 8) {
#pragma unroll
        for (int i = 0; i < 8; ++i) y[i] *= 0.12751743082459868f; }
    const u32x4 w = pack8(y);
    if (hh < 8) *(u32x4*)(P + (size_t)r * INW + hh * 128 + li * 8) = w;
    else { const size_t kvrow = (size_t)(ch.b0 + (r >> ch.lgL)) * KVLEN + ch.koff + (r & (ch.L - 1)); *(u32x4*)(kall + kvrow * 256 + (hh - 8) * 128 + li * 8) = w; }
}
DEVI void headfix_job(const Params& p, const Chunk& ch, int l, int full, int bid, int nb) {
    const int tid = opq_v(threadIdx.x), li = tid & 15, grp = tid >> 4;
    bf16_t* P = (bf16_t*)(p.ws + OFF_P); bf16_t* kall = (bf16_t*)(p.ws + OFF_KALL);
    const float2* rope = (const float2*)(p.ws + OFF_ROPE);
    const int nh = full ? 10 : 2, npairs = ch.nrows * nh;
    for (int pb = bid * 128; pb < npairs; pb += nb * 128) {
        int r[4], hh[4]; u32x4 raw[4];
#pragma unroll
        for (int k = 0; k < 4; ++k) { const int pi = pb + k * 32 + grp; r[k] = full ? pi / 10 : (pi >> 1); hh[k] = full ? pi - r[k] * 10 : 8 + (pi & 1);
            raw[k] = *(const u32x4*)(P + (size_t)r[k] * INW + hh[k] * 128 + li * 8); }
#pragma unroll
        for (int k = 0; k < 4; ++k) headfix_one(p, ch, l, raw[k], r[k], hh[k], li, P, kall, rope);
    }
}
DEVI void conv3x8(const bf16_t* P, int r, int t, int L, int colP, const float* cw, const float* cb, int colW, float* s) {
    float u0[8], u1[8], u2[8];
    ld8bf(P + (size_t)r * INW + colP, u1);
    if (t > 0) ld8bf(P + (size_t)(r - 1) * INW + colP, u0); else {
#pragma unroll
        for (int i = 0; i < 8; ++i) u0[i] = 0.f; }
    if (t < L - 1) ld8bf(P + (size_t)(r + 1) * INW + colP, u2); else {
#pragma unroll
        for (int i = 0; i < 8; ++i) u2[i] = 0.f; }
#pragma unroll
    for (int i = 0; i < 8; ++i) s[i] = cb[colW + i] + cw[colW + i] * u0[i] + cw[3072 + colW + i] * u1[i] + cw[6144 + colW + i] * u2[i];
}
DEVI void hypre_job(const Params& p, const Chunk& ch, int l, float* lds, int bid, int nb) {
    const int tid = opq_v(threadIdx.x); const bf16_t* P = (const bf16_t*)(p.ws + OFF_P); bf16_t* zt = (bf16_t*)(p.ws + OFF_ZT);
    const float* cw = p.in[I_HCW] + (size_t)l * 3 * 3072; const float* cb = p.in[I_HCB] + (size_t)l * 3072;
    const int ntiles = (ch.nrows / 64) * 8;
    for (int tile = bid; tile < ntiles; tile += nb) {
        const int r0 = (tile >> 3) * 64, c0 = (tile & 7) * 128, s = r0 >> ch.lgL, t0 = r0 & (ch.L - 1);
        __syncthreads();
#pragma unroll
        for (int k = 0; k < 2; ++k) { const int task = tid + NTHR * k, tt = task >> 4, cg8 = (task & 15) * 8, c = c0 + cg8;
            float sv[8], sx[8];
            conv3x8(P, r0 + tt, t0 + tt, ch.L, C_HY + c, cw, cb, c, sv);
            conv3x8(P, r0 + tt, t0 + tt, ch.L, C_HY + 2048 + c, cw, cb, 2048 + c, sx);
#pragma unroll
            for (int i = 0; i < 8; ++i) lds[(cg8 + i) * 65 + tt] = sv[i] * sx[i]; }
        __syncthreads();
#pragma unroll
        for (int k = 0; k < 2; ++k) { const int idx = tid + NTHR * k, row = idx >> 3, q8 = (idx & 7) * 8; float v[8];
#pragma unroll
            for (int e = 0; e < 8; ++e) v[e] = lds[row * 65 + q8 + e];
            *(u32x4*)(zt + ((size_t)(s * 1024 + c0 + row)) * ch.L + t0 + q8) = pack8(v); }
    }
}
DEVI void hypost_job(const Params& p, const Chunk& ch, int l, float* lds, int bid, int nb) {
    const int tid = opq_v(threadIdx.x); bf16_t* P = (bf16_t*)(p.ws + OFF_P); const bf16_t* zt = (const bf16_t*)(p.ws + OFF_ZT);
    const float* cw = p.in[I_HCW] + (size_t)l * 3 * 3072; const float* cb = p.in[I_HCB] + (size_t)l * 3072;
    const int ntiles = (ch.nrows / 64) * 8;
    for (int tile = bid; tile < ntiles; tile += nb) {
        const int r0 = (tile >> 3) * 64, c0 = (tile & 7) * 128, s = r0 >> ch.lgL, t0 = r0 & (ch.L - 1);
        __syncthreads();
#pragma unroll
        for (int k = 0; k < 2; ++k) { const int idx = tid + NTHR * k, row = idx >> 3, q8 = (idx & 7) * 8; float v[8];
            ld8bf(zt + ((size_t)(s * 1024 + c0 + row)) * ch.L + t0 + q8, v);
#pragma unroll
            for (int e = 0; e < 8; ++e) lds[row * 65 + q8 + e] = v[e]; }
        __syncthreads();
#pragma unroll
        for (int k = 0; k < 2; ++k) { const int task = tid + NTHR * k, tt = task >> 4, cg8 = (task & 15) * 8, c = c0 + cg8;
            float sx[8], o[8];
            conv3x8(P, r0 + tt, t0 + tt, ch.L, C_HY + 1024 + c, cw, cb, 1024 + c, sx);
#pragma unroll
            for (int i = 0; i < 8; ++i) o[i] = sx[i] * lds[(cg8 + i) * 65 + tt];
            *(u32x4*)(P + (size_t)(r0 + tt) * INW + C_HY + c) = pack8(o); }
    }
}
DEVI void poolpre_job(const Params& p, const Chunk& ch, int bid, int nb) {
    const int tid = opq_v(threadIdx.x); bf16_t* P = (bf16_t*)(p.ws + OFF_P);
    const int ntask = (ch.nrows / 16) * 128, L = ch.L;
    for (int task = bid * NTHR + tid; task < ntask; task += nb * NTHR) {
        const int run = task >> 7, c = (task & 127) * 8, gi = c >> 8, w = 2 << gi, before = w >> 1, after = w - 1 - before;
        const int r0 = run * 16, t0 = r0 & (L - 1), rs = r0 - t0;
        const bf16_t* base = P + (size_t)rs * INW + C_POOL + c;
        float S[8], u[8];
#pragma unroll
        for (int i = 0; i < 8; ++i) S[i] = 0.f;
        { const int lo = max(t0 - before, 0), hi = min(t0 + after, L - 1);
          for (int tt = lo; tt <= hi; ++tt) { ld8bf(base + (size_t)tt * INW, u);
#pragma unroll
              for (int i = 0; i < 8; ++i) S[i] += u[i]; } }
#pragma unroll 4
        for (int k = 0; k < 16; ++k) { const int t = t0 + k; const int lo = max(t - before, 0), hi = min(t + after + 1, L); const float rc = 1.f / (float)(hi - lo);
            ld8bf(base + (size_t)t * INW, u); float o[8];
#pragma unroll
            for (int i = 0; i < 8; ++i) o[i] = S[i] * rc - u[i];
            *(u32x4*)(P + (size_t)(r0 + k) * INW + C_HY + 2048 + c) = pack8(o);
            if (t + 1 + after < L) { ld8bf(base + (size_t)(t + 1 + after) * INW, u);
#pragma unroll
                for (int i = 0; i < 8; ++i) S[i] += u[i]; }
            if (t - before >= 0) { ld8bf(base + (size_t)(t - before) * INW, u);
#pragma unroll
                for (int i = 0; i < 8; ++i) S[i] -= u[i]; }
        }
    }
}
DEVI void ln_job(const Chunk& ch, const float* Y, const float* g, const float* b, float* xl, bf16_t* hdst, const float* mod, int shoff, int scoff, int bid, int nb) {
    const int tid = opq_v(threadIdx.x), wid = tid >> 6, lane = tid & 63;
    for (int r = bid * 8 + wid; r < ch.nrows; r += nb * 8) {
        const float* yp = Y + (size_t)r * DM; f32x4 v[4];
#pragma unroll
        for (int k = 0; k < 4; ++k) v[k] = *(const f32x4*)(yp + k * 256 + lane * 4);
        float s = 0.f;
#pragma unroll
        for (int k = 0; k < 4; ++k) s += v[k][0] + v[k][1] + v[k][2] + v[k][3];
        const float mu = wave_sum(s) * (1.f / DM);
        float q = 0.f;
#pragma unroll
        for (int k = 0; k < 4; ++k) { v[k] = v[k] - mu; q += v[k][0] * v[k][0] + v[k][1] * v[k][1] + v[k][2] * v[k][2] + v[k][3] * v[k][3]; }
        const float rstd = rsqrtf(wave_sum(q) * (1.f / DM) + EPSF);
        const int mi = ch.isctx ? 8 : ch.b0 + (r >> ch.lgL);
#pragma unroll
        for (int k = 0; k < 4; ++k) { const int c = k * 256 + lane * 4; const f32x4 gg = *(const f32x4*)(g + c), bb = *(const f32x4*)(b + c);
            const f32x4 o = v[k] * rstd * gg + bb;
            *(f32x4*)(xl + (size_t)r * DM + c) = o;
            if (hdst) { const f32x4 sc = *(const f32x4*)(mod + (size_t)mi * 6144 + scoff + c), sh = *(const f32x4*)(mod + (size_t)mi * 6144 + shoff + c);
                const f32x4 h = o * (sc + 1.f) + sh; u32x2 w; w.x = cvt_pk_bf16(h[0], h[1]); w.y = cvt_pk_bf16(h[2], h[3]);
                *(u32x2*)(hdst + (size_t)r * DM + c) = w; } }
    }
}

#define XB_TMO      128
#define XB_XCNT(j)  (256  + 64 * (j))
#define XB_XSUB(j)  (1280 + 64 * (j))
#define XB_XGEN(j)  (2304 + 64 * (j))
#define XB_TOP      3328
#define XB_TOPGEN   3392
#define XCD_BAR_WORDS 3456
#define XB_SPIN_CAP (1u << 20)
DEVI unsigned xb_ld(unsigned* p)              { return __hip_atomic_load(p, __ATOMIC_RELAXED, __HIP_MEMORY_SCOPE_AGENT); }
DEVI unsigned xb_add(unsigned* p, unsigned v) { return __hip_atomic_fetch_add(p, v, __ATOMIC_RELAXED, __HIP_MEMORY_SCOPE_AGENT); }
DEVI unsigned xb_xcc_id() { return (unsigned)__builtin_amdgcn_s_getreg((3 << 11) | 20) & 0xFu; }
#define XB_SPIN(cond, bar) do { unsigned _sp = 0; while (cond) { __builtin_amdgcn_s_sleep(1); \
    if ((++_sp & 255u) == 0u) { if (xb_ld(&(bar)[XB_TMO])) break; if (_sp > XB_SPIN_CAP) { atomicAdd(&(bar)[XB_TMO], 1u); break; } } } } while (0)
struct XcdBarrier { unsigned* bar; unsigned x; volatile LAS unsigned* st; };
DEVI XcdBarrier xcd_barrier_post(unsigned* bar, volatile LAS unsigned* st) {
    XcdBarrier b; b.bar = bar; b.x = xb_xcc_id(); b.st = st;
    if (threadIdx.x == 0) (void)xb_add(&bar[XB_XCNT(b.x)], 1u);
    return b;
}
DEVI void xcd_barrier_complete(unsigned* bar, unsigned x, unsigned& nloc, unsigned& nx) {
    const unsigned G = gridDim.x * gridDim.y * gridDim.z;
    unsigned sum, cnt, mine, sp = 0u;
    for (;;) {
        sum = 0u; cnt = 0u; mine = 0u;
#pragma unroll
        for (unsigned j = 0; j < 16; ++j) { const unsigned c = xb_ld(&bar[XB_XCNT(j)]); sum += c; cnt += (c > 0u) ? 1u : 0u; mine = (j == x) ? c : mine; }
        if (sum == G) break;
        __builtin_amdgcn_s_sleep(1);
        if ((++sp & 255u) == 0u) { if (xb_ld(&bar[XB_TMO])) break; if (sp > XB_SPIN_CAP) { atomicAdd(&bar[XB_TMO], 1u); break; } }
    }
    nloc = mine > 0u ? mine : 1u; nx = cnt > 0u ? cnt : 1u;
}
DEVI void xcd_barrier(const XcdBarrier& b) {
    asm volatile("s_waitcnt vmcnt(0)" ::: "memory");
    __syncthreads();
    if (threadIdx.x == 0) {
        unsigned* bar = b.bar;
        __builtin_amdgcn_s_waitcnt(0);
        unsigned nloc = b.st[0], nx = b.st[1];
        if (nloc == 0u) { xcd_barrier_complete(bar, b.x, nloc, nx); b.st[0] = nloc; b.st[1] = nx; }
        const unsigned old = xb_add(&bar[XB_XSUB(b.x)], 1u);
        const unsigned gen = old / nloc;
        if (old + 1u == (gen + 1u) * nloc) {
            __builtin_amdgcn_fence(__ATOMIC_RELEASE, "agent");
            asm volatile("s_waitcnt vmcnt(0)" ::: "memory");
            const unsigned og = xb_add(&bar[XB_TOP], 1u);
            const unsigned tg = og / nx;
            if (og + 1u == (tg + 1u) * nx) xb_add(&bar[XB_TOPGEN], 1u);
            else XB_SPIN(xb_ld(&bar[XB_TOPGEN]) == tg, bar);
            __builtin_amdgcn_fence(__ATOMIC_ACQUIRE, "agent");
            xb_add(&bar[XB_XGEN(b.x)], 1u);
            asm volatile("s_waitcnt vmcnt(0)" ::: "memory");
        } else {
            XB_SPIN(xb_ld(&bar[XB_XGEN(b.x)]) == gen, bar);
            __builtin_amdgcn_fence(__ATOMIC_ACQUIRE, "agent");
            asm volatile("s_waitcnt vmcnt(0)" ::: "memory");
        }
    }
    __syncthreads();
}

__global__ void __launch_bounds__(NTHR, 2) fwd_megakernel(Params p) {
    extern __shared__ __attribute__((aligned(16))) unsigned char lds[];
    cg::grid_group grid = cg::this_grid();
    const int bid = opq_s(blockIdx.x), nb = opq_s(gridDim.x), tid = opq_v(threadIdx.x);
    unsigned char* ws = p.ws;
    float* ldsf = (float*)lds;
    bf16_t* P = (bf16_t*)(ws + OFF_P);
    float* MOD = (float*)(ws + OFF_MOD);
    volatile LAS unsigned* xst = (volatile LAS unsigned*)(LAS unsigned char*)(lds + LDS_BYTES - 16);
    if (tid < 4) xst[tid] = 0u;
    if (bid == 0) for (int i = tid; i < XCD_BAR_WORDS; i += NTHR) __hip_atomic_store((unsigned*)(ws + OFF_BAR) + i, 0u, __ATOMIC_RELAXED, __HIP_MEMORY_SCOPE_AGENT);
    __syncthreads();

    for (int rep = 0; rep < 1 + PROBE_PREP; ++rep) {
    for (int l = 0; l < 2; ++l) {
        wt_transpose<0>(p.in[I_WIN] + (size_t)l * DM * INW, DM, INW, (bf16_t*)(ws + OFF_WIN + l * SZ_WIN), ldsf, bid, nb);
        wt_transpose<0>(p.in[I_WBR] + (size_t)(l * 3 + 0) * DM * DM, DM, DM, (bf16_t*)(ws + OFF_WBR + l * SZ_WBR), ldsf, bid, nb);
        wt_transpose<0>(p.in[I_WBR] + (size_t)(l * 3 + 1) * DM * DM, DM, DM, (bf16_t*)(ws + OFF_WBR + l * SZ_WBR) + (size_t)DM * DM, ldsf, bid, nb);
        wt_transpose<0>(p.in[I_WOUT] + (size_t)l * DM * DM, DM, DM, (bf16_t*)(ws + OFF_WOUT + l * SZ_WOUT), ldsf, bid, nb);
        wt_transpose<1>(p.in[I_FW1] + (size_t)l * DM * DFF, DM, DFF, (bf16_t*)(ws + OFF_W13 + l * SZ_W13), ldsf, bid, nb);
        wt_transpose<2>(p.in[I_FW3] + (size_t)l * DM * DFF, DM, DFF, (bf16_t*)(ws + OFF_W13 + l * SZ_W13), ldsf, bid, nb);
        wt_transpose<0>(p.in[I_FW2] + (size_t)l * DFF * DM, DFF, DM, (bf16_t*)(ws + OFF_W2 + l * SZ_W2), ldsf, bid, nb);
        wpc_job(p.in[I_POOLW] + (size_t)l * 4 * 256 * 256, p.in[I_POOLS] + l * DM, p.in[I_WBR] + (size_t)(l * 3 + 2) * DM * DM,
                (bf16_t*)(ws + OFF_WBR + l * SZ_WBR) + (size_t)2 * DM * DM, ldsf, bid, nb);
    }
    modp_job(p, (float*)(ws + OFF_MODP), ldsf, bid, nb);
    for (int idx = bid * NTHR + tid; idx < 128 * 32; idx += nb * NTHR) { const int pos = idx >> 5, f = idx & 31; const float inv = powf(10000.f, -(float)f / 32.f); float s, c; sincosf((float)pos * inv, &s, &c);
        ((float2*)(ws + OFF_ROPE))[idx] = make_float2(c, s); }
    gen_filter(p, 0, SEQ, 0, (float*)(ws + OFF_P), ldsf, bid, nb);
    gen_filter(p, 1, SEQ, 0, (float*)(ws + OFF_P) + (size_t)1024 * FFTN, ldsf, bid, nb);
    gen_filter(p, 0, CTXL, 1, (float*)(ws + OFF_KC), ldsf, bid, nb);
    }
    grid.sync();
    (void)xcd_barrier_post((unsigned*)(ws + OFF_BAR), xst);
    for (int rep = 0; rep < 1 + PROBE_PREP; ++rep) {
    for (int idx = bid * NTHR + tid; idx < 2 * 9 * 6144; idx += nb * NTHR) { const int l = idx / (9 * 6144), rem = idx % (9 * 6144), j = rem % 6144; float a = p.in[I_BADA][l * 6144 + j];
        for (int ks = 0; ks < 16; ++ks) a += ((const float*)(ws + OFF_MODP))[((size_t)l * 16 + ks) * 9 * 6144 + rem];
        MOD[idx] = a; }
    kf_job((const float*)(ws + OFF_P), p.in[I_HYD], (float2*)(ws + OFF_KF), (char*)lds, bid, nb);
    kf_job((const float*)(ws + OFF_P) + (size_t)1024 * FFTN, p.in[I_HYD] + DM, (float2*)(ws + OFF_KF + SZ_KF), (char*)lds, bid, nb);
    }
    GSYNC();
    for (int rep = 0; rep < 1 + PROBE_PREP; ++rep) {
    for (size_t i4 = (size_t)bid * NTHR + tid; i4 < (size_t)NTOK * DM / 4; i4 += (size_t)nb * NTHR) {
        const size_t e = i4 * 4; const int r = (int)(e >> 10), c = (int)(e & 1023);
        const bool isc = r >= NLAT; const int mi = isc ? 8 : (r >> 13);
        const f32x4 xv = isc ? *(const f32x4*)(p.in[I_CTX] + (e - (size_t)NLAT * DM)) : *(const f32x4*)(p.in[I_X] + e);
        const f32x4 sh = *(const f32x4*)(MOD + (size_t)mi * 6144 + c), sc = *(const f32x4*)(MOD + (size_t)mi * 6144 + 1024 + c);
        const f32x4 h = xv * (sc + 1.f) + sh; u32x2 w; w.x = cvt_pk_bf16(h[0], h[1]); w.y = cvt_pk_bf16(h[2], h[3]);
        *(u32x2*)((bf16_t*)(ws + OFF_H) + e) = w;
    }
    }
    GSYNC();

    for (int l_ = 0; l_ < 2; ++l_) {
        const int l = opq_s(l_);
        const float* modl = MOD + (size_t)l * 9 * 6144;
        const bf16_t* Wint = (const bf16_t*)(ws + OFF_WIN + l * SZ_WIN);
        const bf16_t* Wbr = (const bf16_t*)(ws + OFF_WBR + l * SZ_WBR);
        for (int grp_ = 0; grp_ < 3; ++grp_) {
            const int grp = opq_s(grp_);
            const int ci_lo = grp == 0 ? -1 : 2 * (grp - 1), ci_hi = grp == 0 ? 0 : ci_lo + 2;
            const int gfull = !(grp == 0 && l == 1);
          for (int ci_ = ci_lo; ci_ < ci_hi; ++ci_) {
            const int ci = opq_s(ci_);
            const Chunk ch = mk_chunk(ci, p);
            const int full = gfull;
            { pg8::Gemm g; g.a0 = g.a1 = g.a2 = 0u; g.bseg = 0; g.A = (const bf16_t*)(ws + OFF_H) + (size_t)ch.row0g * DM; g.lda = DM; g.K = DM; g.M = ch.nrows;
              EpiA E; E.P = P; E.vall = (bf16_t*)(ws + OFF_VALL); E.lgL = ch.lgL; E.Lm1 = ch.L - 1; E.b0 = ch.b0; E.koff = ch.koff;
              if (full) { g.Bt = Wint; g.N = INW; E.col_off = 0; } else { g.Bt = Wint + (size_t)C_K * DM; g.N = 512; E.col_off = C_K; }
              pg8::StaticOrder S; S.init(g.M, g.N, nb, bid);
              for (int rep = 0; rep < 1 + PROBE_GEMM; ++rep) pg8::gemm_phase<EpiA>((LAS unsigned char*)lds, g, S, E); }
            GSYNC();
            for (int rep = 0; rep < 1 + PROBE_EW; ++rep) {
            headfix_job(p, ch, l, full, bid, nb);
            if (full) hypre_job(p, ch, l, ldsf, bid, nb); }
            GSYNC();
            if (!full) continue;
            { const int nqb = ch.L / 256, nun = (ch.nrows / ch.L) * NHEAD * nqb;
              float gq = 0.f, gk = 0.f;
              for (int i = 0; i < HD; ++i) { gq = fmaxf(gq, fabsf(p.in[I_QG][l * HD + i])); gk = fmaxf(gk, fabsf(p.in[I_KG][l * HD + i])); }
              const float mshift = 11.313708498984761f * gq * gk * 1.02f;
              for (int u = bid; u < nun; u += nb) {
                  int qb = u % nqb, h = (u / nqb) % NHEAD, s = u / (nqb * NHEAD);
                  if (!ch.isctx && nb == 256) {
                      const int xcd = bid & 7, slot = bid >> 3, rnd = u >> 8, g4 = xcd & 3, sub = (xcd >> 2) + 2 * rnd;
                      s = g4 >> 1; h = (g4 & 1) * 4 + sub; qb = slot; }
                  const int b = ch.b0 + s;
                  bf16_t* Qb = P + (size_t)(s * ch.L + qb * 256) * INW + h * HD;
                  const bf16_t* Kh = (const bf16_t*)(ws + OFF_KALL) + (size_t)b * KVLEN * 256 + (h >> 2) * HD;
                  const bf16_t* Vh = (const bf16_t*)(ws + OFF_VALL) + (size_t)b * KVLEN * 256 + (h >> 2) * HD;
                  att::attn_dense_body(Qb, Kh, Vh, Qb, ch.isctx ? CTXL : KVLEN, INW, 256, INW, mshift, (char*)lds);
              } }
            if (ch.isctx) ctxconv_job((bf16_t*)(ws + OFF_ZT), (const float*)(ws + OFF_KC), p.in[I_HYD] + l * DM, ldsf, bid, nb);
            else fftconv_job((const bf16_t*)(ws + OFF_ZT), (bf16_t*)(ws + OFF_ZT), (const float2*)(ws + OFF_KF + l * SZ_KF), (char*)lds, bid, nb);
            GSYNC();
            for (int rep = 0; rep < 1 + PROBE_EW; ++rep) { hypost_job(p, ch, l, ldsf, bid, nb); poolpre_job(p, ch, bid, nb); }
            GSYNC();
            { pg8::Gemm g; g.K = DM; g.M = ch.nrows; g.N = DM; g.A = P; g.lda = INW; g.Bt = Wbr; g.a0 = C_HY * 2; g.a1 = C_Q * 2; g.a2 = (C_HY + 2048) * 2; g.bseg = (size_t)DM * DM * 2;
              pg8::StaticOrder S; S.init(g.M, g.N, nb, bid, 3);
              EpiMerge E; E.P = P; E.mg = (bf16_t*)(ws + OFF_R2) + (size_t)(ci < 0 ? 0 : (ci & 1)) * CH_ROWS * DM;
              __syncthreads();
              for (int rep = 0; rep < 1 + PROBE_GEMM; ++rep) pg8::gemm_phase<EpiMerge>((LAS unsigned char*)lds, g, S, E); }
            GSYNC();
          }
            if (!gfull) continue;
            Chunk sc = mk_chunk(ci_lo, p);
            if (grp > 0) sc.nrows = 2 * CH_ROWS;
            bf16_t* H2 = (bf16_t*)(ws + OFF_H) + (size_t)sc.row0g * DM;
            { pg8::Gemm g; g.a0 = g.a1 = g.a2 = 0u; g.bseg = 0; g.A = (const bf16_t*)(ws + OFF_R2); g.lda = DM; g.K = DM; g.M = sc.nrows; g.N = DM; g.Bt = (const bf16_t*)(ws + OFF_WOUT + l * SZ_WOUT);
              pg8::StaticOrder S; S.init(g.M, g.N, nb, bid);
              EpiRes E; E.xl = l == 0 ? (sc.isctx ? p.in[I_CTX] : p.in[I_X] + (size_t)sc.row0g * DM) : sc.xl; E.gmod = modl + 2048; E.Y = sc.xl; E.lgL = sc.lgL; E.b0 = sc.b0; E.isctx = sc.isctx;
              __syncthreads();
              for (int rep = 0; rep < 1 + PROBE_GEMM; ++rep) pg8::gemm_phase<EpiRes>((LAS unsigned char*)lds, g, S, E); }
            GSYNC();
            for (int rep = 0; rep < 1 + PROBE_EW; ++rep) ln_job(sc, sc.xl, p.in[I_LN1G] + l * DM, p.in[I_LN1B] + l * DM, sc.xl, H2, modl, 3072, 4096, bid, nb);
            GSYNC();
            { pg8::Gemm g; g.a0 = g.a1 = g.a2 = 0u; g.bseg = 0; g.A = H2; g.lda = DM; g.K = DM; g.M = sc.nrows; g.N = 2 * DFF; g.Bt = (const bf16_t*)(ws + OFF_W13 + l * SZ_W13);
              pg8::StaticOrder S; S.init(g.M, g.N, nb, bid);
              EpiF1 E; E.G = P;
              for (int rep = 0; rep < 1 + PROBE_GEMM; ++rep) pg8::gemm_phase<EpiF1>((LAS unsigned char*)lds, g, S, E); }
            GSYNC();
            { pg8::Gemm g; g.a0 = g.a1 = g.a2 = 0u; g.bseg = 0; g.A = P; g.lda = DFF; g.K = DFF; g.M = sc.nrows; g.N = DM; g.Bt = (const bf16_t*)(ws + OFF_W2 + l * SZ_W2);
              pg8::StaticOrder S; S.init(g.M, g.N, nb, bid);
              EpiRes E; E.xl = sc.xl; E.gmod = modl + 5120; E.Y = sc.xl; E.lgL = sc.lgL; E.b0 = sc.b0; E.isctx = sc.isctx;
              for (int rep = 0; rep < 1 + PROBE_GEMM; ++rep) pg8::gemm_phase<EpiRes>((LAS unsigned char*)lds, g, S, E); }
            GSYNC();
            for (int rep = 0; rep < 1 + PROBE_EW; ++rep) ln_job(sc, sc.xl, p.in[I_LN2G] + l * DM, p.in[I_LN2B] + l * DM, sc.xl, l == 0 ? H2 : (bf16_t*)nullptr,
                   MOD + (size_t)9 * 6144, 0, 1024, bid, nb);
            if (!(l == 1 && grp == 2)) GSYNC();
        }
    }
}

extern "C" void kernel_launch(void* const* d_in, const int* in_sizes, int n_in, void* d_out, int out_size, void* d_ws, size_t ws_size, hipStream_t stream) {
    static int grid_blocks = 0;
    if (grid_blocks == 0) {
        if (n_in != 29 || out_size != NLAT * DM || ws_size < WS_END) { fprintf(stderr, "kernel_launch: unexpected shapes (n_in %d out %d ws %zu need %zu)\n", n_in, out_size, ws_size, (size_t)WS_END); grid_blocks = -1; return; }
        int dev = 0, cus = 0, per_cu = 0;
        hipGetDevice(&dev);
        hipDeviceGetAttribute(&cus, hipDeviceAttributeMultiprocessorCount, dev);
        if (hipFuncSetAttribute((const void*)fwd_megakernel, hipFuncAttributeMaxDynamicSharedMemorySize, LDS_BYTES) != hipSuccess) { fprintf(stderr, "kernel_launch: hipFuncSetAttribute failed\n"); grid_blocks = -1; return; }
        if (hipOccupancyMaxActiveBlocksPerMultiprocessor(&per_cu, (const void*)fwd_megakernel, NTHR, LDS_BYTES) != hipSuccess || per_cu < 1) { fprintf(stderr, "kernel_launch: occupancy query failed (%d)\n", per_cu); per_cu = 1; (void)hipGetLastError(); }
        grid_blocks = cus * 1;
        (void)per_cu;
    }
    if (grid_blocks < 0) return;
    Params p{};
    for (int i = 0; i < 29; ++i) p.in[i] = (const float*)d_in[i];
    p.out = (float*)d_out; p.ws = (unsigned char*)d_ws;
    void* args[] = {&p};
    hipError_t e = hipLaunchCooperativeKernel((const void*)fwd_megakernel, dim3(grid_blocks), dim3(NTHR), args, LDS_BYTES, stream);
    if (e != hipSuccess) fprintf(stderr, "cooperative launch failed: %s (grid %d)\n", hipGetErrorString(e), grid_blocks);
}
```

```cpp
#include <hip/hip_runtime.h>
#include <hip/hip_cooperative_groups.h>
#include <cstdio>
#include <cstdint>
namespace cg = cooperative_groups;
#ifndef PROBE_SYNC
#define PROBE_SYNC 0
#endif
#ifndef PROBE_FFT
#define PROBE_FFT 0
#endif
#ifndef PROBE_ATT
#define PROBE_ATT 0
#endif
#ifndef PROBE_GEMM
#define PROBE_GEMM 0
#endif
#ifndef PROBE_PREP
#define PROBE_PREP 0
#endif
#ifndef PROBE_EW
#define PROBE_EW 0
#endif
#define GSYNC() do { XcdBarrier xb_; xb_.bar = (unsigned*)(p.ws + OFF_BAR); xb_.x = xb_xcc_id(); xb_.st = (volatile LAS unsigned*)(LAS unsigned char*)(lds + LDS_BYTES - 16); xcd_barrier(xb_); if (PROBE_SYNC) xcd_barrier(xb_); } while (0)

#define DEVI __device__ __forceinline__
#define LAS __attribute__((address_space(3)))
typedef unsigned short bf16_t;
typedef short bf16x8 __attribute__((ext_vector_type(8)));
typedef short s16x4 __attribute__((ext_vector_type(4)));
typedef float f32x4 __attribute__((ext_vector_type(4)));
typedef float f32x16 __attribute__((ext_vector_type(16)));
typedef unsigned u32x4 __attribute__((ext_vector_type(4)));
typedef unsigned u32x2 __attribute__((ext_vector_type(2)));

constexpr int DM = 1024, NBATCH = 8, SEQ = 8192, CTXL = 256, NHEAD = 8, HD = 128;
constexpr int INW = 8704, C_Q = 0, C_K = 1024, C_V = 1280, C_HY = 1536, C_POOL = 4608, C_GATE = 5632;
constexpr int DFF = 2816;
constexpr int NLAT = NBATCH * SEQ, NCTX = NBATCH * CTXL, NTOK = NLAT + NCTX;
constexpr int CH_ROWS = 16384;
constexpr int KVLEN = SEQ + CTXL;
constexpr float DN_ALPHA = 1.4142135623730951f;
constexpr float EPSF = 1e-6f;
constexpr int NTHR = 512;
constexpr int FFTN = 16384;
constexpr int LDS_BYTES = 132 * 1024;

constexpr size_t al256(size_t x) { return (x + 255) / 256 * 256; }
constexpr size_t SZ_WIN = (size_t)INW * DM * 2, SZ_WBR = (size_t)3 * DM * DM * 2, SZ_WOUT = (size_t)DM * DM * 2, SZ_W13 = (size_t)2 * DFF * DM * 2, SZ_W2 = (size_t)DM * DFF * 2;
constexpr size_t OFF_WIN = 0;
constexpr size_t OFF_WBR = OFF_WIN + 2 * SZ_WIN;
constexpr size_t OFF_WOUT = OFF_WBR + 2 * SZ_WBR;
constexpr size_t OFF_W13 = OFF_WOUT + 2 * SZ_WOUT;
constexpr size_t OFF_W2 = OFF_W13 + 2 * SZ_W13;
constexpr size_t OFF_MODP = OFF_W2 + 2 * SZ_W2;
constexpr size_t OFF_MOD = OFF_MODP + (size_t)2 * 16 * 9 * 6144 * 4;
constexpr size_t OFF_ROPE = OFF_MOD + (size_t)2 * 9 * 6144 * 4;
constexpr size_t SZ_KF = (size_t)1024 * FFTN * 8;
constexpr size_t OFF_KF = OFF_ROPE + (size_t)128 * 32 * 8;
constexpr size_t OFF_KC = OFF_KF + 2 * SZ_KF;
constexpr size_t OFF_H = OFF_KC + (size_t)1024 * 512 * 4;
constexpr size_t OFF_XLC = OFF_H + (size_t)NTOK * DM * 2;
constexpr size_t OFF_P = OFF_XLC + (size_t)NCTX * DM * 4;
constexpr size_t OFF_ZT = OFF_P + (size_t)CH_ROWS * INW * 2;
constexpr size_t OFF_KALL = OFF_ZT + (size_t)2 * 1024 * SEQ * 2;
constexpr size_t OFF_VALL = OFF_KALL + (size_t)NBATCH * KVLEN * 256 * 2;
constexpr size_t OFF_R2 = OFF_VALL + (size_t)NBATCH * KVLEN * 256 * 2;
constexpr size_t OFF_BAR = OFF_R2 + (size_t)2 * CH_ROWS * DM * 2;
constexpr size_t WS_END = OFF_BAR + 16384;

struct Params { const float* in[29]; float* out; unsigned char* ws; };
enum { I_X = 0, I_C, I_CTX, I_CCTX, I_WADA, I_BADA, I_WIN, I_QG, I_KG, I_HCW, I_HCB, I_HW1, I_HB1, I_HFREQ, I_HW2, I_HB2, I_HW3, I_HYD, I_POOLW, I_POOLS, I_WBR, I_WOUT,
       I_LN1G, I_LN1B, I_LN2G, I_LN2B, I_FW1, I_FW3, I_FW2 };

DEVI int opq_s(int x) { asm volatile("" : "+s"(x)); return x; }
DEVI int opq_v(int x) { asm volatile("" : "+v"(x)); return x; }
DEVI float bf2f(unsigned short b) { return __uint_as_float(((unsigned)b) << 16); }
DEVI unsigned cvt_pk_bf16(float lo, float hi) { unsigned r; asm volatile("v_cvt_pk_bf16_f32 %0, %1, %2" : "=v"(r) : "v"(lo), "v"(hi)); return r; }
DEVI u32x4 pack8(const float* v) { u32x4 w; w.x = cvt_pk_bf16(v[0], v[1]); w.y = cvt_pk_bf16(v[2], v[3]); w.z = cvt_pk_bf16(v[4], v[5]); w.w = cvt_pk_bf16(v[6], v[7]); return w; }
DEVI void unpack8(u32x4 w, float* o) {
    o[0] = __uint_as_float(w.x << 16); o[1] = __uint_as_float(w.x & 0xffff0000u); o[2] = __uint_as_float(w.y << 16); o[3] = __uint_as_float(w.y & 0xffff0000u);
    o[4] = __uint_as_float(w.z << 16); o[5] = __uint_as_float(w.z & 0xffff0000u); o[6] = __uint_as_float(w.w << 16); o[7] = __uint_as_float(w.w & 0xffff0000u); }
DEVI void ld8bf(const bf16_t* p, float* o) { unpack8(*(const u32x4*)p, o); }
DEVI float sigmoidf_(float x) { return __builtin_amdgcn_rcpf(1.f + __expf(-x)); }
DEVI float wave_sum(float v) { for (int m = 32; m >= 1; m >>= 1) v += __shfl_xor(v, m); return v; }

struct Chunk { int isctx, nrows, L, lgL, b0, row0g, koff; float* xl; };
DEVI Chunk mk_chunk(int ci, const Params& p) {
    Chunk c;
    if (ci < 0) { c.isctx = 1; c.nrows = NCTX; c.L = CTXL; c.lgL = 8; c.b0 = 0; c.row0g = NLAT; c.koff = 0; c.xl = (float*)(p.ws + OFF_XLC); }
    else { c.isctx = 0; c.nrows = CH_ROWS; c.L = SEQ; c.lgL = 13; c.b0 = 2 * ci; c.row0g = ci * CH_ROWS; c.koff = CTXL; c.xl = p.out + (size_t)ci * CH_ROWS * DM; }
    return c;
}

namespace pg8 {
constexpr int BM = 256, BK = 64, HALF = 128, HTB = HALF * BK * 2, STAGE_BYTES = 8 * HTB, NXCD = 8, WGM = 8;
DEVI int lds_byte(int r, int c) { const int st = (r >> 4) * 2 + (c >> 5), rr = r & 15, cc = c & 31, ob = rr * 64 + cc * 2; return st * 1024 + (ob ^ (((ob >> 9) & 1) << 5)); }
DEVI void stage_rc(int b, int& R, int& C) { const int st = b / 1024, sb = b % 1024, swz = sb ^ (((sb >> 9) & 1) << 5); R = (st >> 1) * 16 + swz / 64; C = (st & 1) * 32 + (swz % 64) / 2; }
DEVI int perm32(int rho) { const int n = rho >> 4, i = rho & 15; return 8 * (i >> 2) + 4 * n + (i & 3); }
struct Unit { int pm, pn, seg; };
struct Gemm { const bf16_t* A; const bf16_t* Bt; int M, N, K, lda; unsigned a0, a1, a2; size_t bseg; };
struct StaticOrder {
    int nM, nN, nwg, G, c, nseg;
    DEVI void init(int M, int N, int G_, int c_, int nseg_ = 1) { nM = M / BM; nN = N / BM; nwg = nM * nN; G = G_; c = c_; nseg = nseg_; }
    DEVI bool next(int i, Unit& u) const {
        const int ib = i / nseg; u.seg = i - ib * nseg;
        const long L = (long)ib * G + c; if (L >= nwg) return false;
        int wgid = (int)L; { const int q = nwg / NXCD, r = nwg % NXCD, xcd = wgid % NXCD, off = wgid / NXCD; wgid = (xcd < r ? xcd * (q + 1) : r * (q + 1) + (xcd - r) * q) + off; }
        const int nig = WGM * nN, gid = wgid / nig, fm = gid * WGM, gsz = (nM - fm) < WGM ? (nM - fm) : WGM;
        u.pm = fm + ((wgid % nig) % gsz); u.pn = (wgid % nig) / gsz; return true;
    }
};
template <class Epi>
DEVI void gemm_phase(LAS unsigned char* lds, const Gemm g, const StaticOrder& S, const Epi& E) {
    const int tid = opq_v(threadIdx.x), wid = __builtin_amdgcn_readfirstlane(tid >> 6), lane = tid & 63, wr = wid >> 2, wc = wid & 3, fr = lane & 15, fq = lane >> 4;
    const int K = g.K, nt = K / BK;
    unsigned voffA[2], voffB[2];
#pragma unroll
    for (int i = 0; i < 2; ++i) { int R, C; stage_rc(tid * 16 + i * 8192, R, C); const int Rb = (R & ~31) + perm32(R & 31);
        voffA[i] = (unsigned)(R * g.lda + C) * 2u; voffB[i] = (unsigned)(Rb * K + C) * 2u; }
    const size_t kstep = (size_t)(BK * 2);
    const size_t hstepA = (size_t)HALF * g.lda * 2, hstepB = (size_t)HALF * K * 2;
    const size_t tstepA = 2 * hstepA, tstepB = 2 * hstepB;
    const unsigned ldsw = (unsigned)wid * 1024u;
    const int aoff = lds_byte(wr * 64 + fr, fq * 8), boff = lds_byte(wc * 32 + fr, fq * 8);
#define PG8_SA(b, h) (((b) * 2 + (h)) * HTB)
#define PG8_SB(b, h) ((4 + (b) * 2 + (h)) * HTB)
#define PG8_STAGE(bufoff, gbase, voff) do { _Pragma("unroll") for (int _i = 0; _i < 2; ++_i) \
        __builtin_amdgcn_global_load_lds((const unsigned*)((const char*)(gbase) + (voff)[_i]), (LAS unsigned*)(lds + (bufoff) + ldsw + _i * 8192), 16, 0, 0); } while (0)
#define PG8_LDA(dst, b, h) do { _Pragma("unroll") for (int m = 0; m < 4; ++m) _Pragma("unroll") for (int k = 0; k < 2; ++k) dst[m][k] = *(const LAS bf16x8*)(lds + PG8_SA(b, h) + aoff + m * 2048 + k * 1024); } while (0)
#define PG8_LDB(dst, b, h) do { _Pragma("unroll") for (int n = 0; n < 2; ++n) _Pragma("unroll") for (int k = 0; k < 2; ++k) dst[n][k] = *(const LAS bf16x8*)(lds + PG8_SB(b, h) + boff + n * 2048 + k * 1024); } while (0)
#define PG8_MMA(ai, bj, At, Bt) do { __builtin_amdgcn_s_setprio(1); _Pragma("unroll") for (int m = 0; m < 4; ++m) _Pragma("unroll") for (int n = 0; n < 2; ++n) _Pragma("unroll") for (int k = 0; k < 2; ++k) \
        acc[ai][bj][m][n] = __builtin_amdgcn_mfma_f32_16x16x32_bf16(Bt[n][k], At[m][k], acc[ai][bj][m][n], 0, 0, 0); __builtin_amdgcn_s_setprio(0); } while (0)
#define PG8_WAIT_V(n) asm volatile("s_waitcnt vmcnt(" #n ")" ::: "memory")
#define PG8_WAIT_L(n) asm volatile("s_waitcnt lgkmcnt(" #n ")" ::: "memory")
#define PG8_BAR __builtin_amdgcn_s_barrier()
#define PG8_SCHED __builtin_amdgcn_sched_barrier(0)
    Unit cur, nxt; int ui = 0;
    if (!S.next(0, cur)) return;
    f32x4 acc[2][2][4][2];
#pragma unroll
    for (int a = 0; a < 2; ++a)
#pragma unroll
        for (int b = 0; b < 2; ++b)
#pragma unroll
            for (int m = 0; m < 4; ++m)
#pragma unroll
                for (int n = 0; n < 2; ++n) acc[a][b][m][n] = (f32x4){0.f, 0.f, 0.f, 0.f};
    bf16x8 At[4][2], B0[2][2], B1[2][2];
#define PG8_ABASE(u) ((const char*)g.A + ((u).seg == 0 ? g.a0 : ((u).seg == 1 ? g.a1 : g.a2)) + (size_t)(u).pm * tstepA)
#define PG8_BBASE(u) ((const char*)g.Bt + (size_t)(u).seg * g.bseg + (size_t)(u).pn * tstepB)
    const char* cA = PG8_ABASE(cur); const char* cB = PG8_BBASE(cur);
    PG8_STAGE(PG8_SB(0, 0), cB, voffB); PG8_STAGE(PG8_SA(0, 0), cA, voffA); PG8_STAGE(PG8_SB(0, 1), cB + hstepB, voffB); PG8_STAGE(PG8_SA(0, 1), cA + hstepA, voffA);
    if (wr == 1) PG8_BAR;
    PG8_WAIT_V(4); PG8_BAR;
    PG8_STAGE(PG8_SB(1, 0), cB + kstep, voffB); PG8_STAGE(PG8_SA(1, 0), cA + kstep, voffA); PG8_STAGE(PG8_SB(1, 1), cB + hstepB + kstep, voffB);
    PG8_WAIT_V(6); PG8_BAR;
    for (;;) {
        const bool has_next = S.next(ui + 1, nxt);
        const char* nA = has_next ? PG8_ABASE(nxt) : cA; const char* nB = has_next ? PG8_BBASE(nxt) : cB;
        for (int t = 0; t < nt; t += 2) {
            const bool last = (t == nt - 2);
            const char* a1 = cA + (size_t)(t + 1) * kstep;
            const char* a2 = last ? nA : cA + (size_t)(t + 2) * kstep; const char* b2 = last ? nB : cB + (size_t)(t + 2) * kstep;
            const char* a3 = a2 + kstep; const char* b3 = b2 + kstep;
            PG8_LDB(B0, 0, 0); PG8_SCHED; PG8_LDA(At, 0, 0); PG8_STAGE(PG8_SA(1, 1), a1 + hstepA, voffA);
            PG8_WAIT_L(8); PG8_BAR; PG8_WAIT_L(0); PG8_MMA(0, 0, At, B0); PG8_BAR; PG8_SCHED;
            PG8_LDB(B1, 0, 1); PG8_STAGE(PG8_SB(0, 0), b2, voffB);
            PG8_BAR; PG8_WAIT_L(0); PG8_MMA(0, 1, At, B1); PG8_BAR;
            PG8_LDA(At, 0, 1); PG8_STAGE(PG8_SA(0, 0), a2, voffA);
            PG8_BAR; PG8_WAIT_L(0); PG8_MMA(1, 0, At, B0); PG8_BAR; PG8_SCHED;
            PG8_STAGE(PG8_SB(0, 1), b2 + hstepB, voffB);
            PG8_WAIT_V(6); PG8_BAR; PG8_MMA(1, 1, At, B1); PG8_BAR;
            PG8_LDB(B0, 1, 0); PG8_SCHED; PG8_LDA(At, 1, 0); PG8_STAGE(PG8_SA(0, 1), a2 + hstepA, voffA);
            PG8_WAIT_L(8); PG8_BAR; PG8_WAIT_L(0); PG8_MMA(0, 0, At, B0); PG8_BAR; PG8_SCHED;
            PG8_LDB(B1, 1, 1); PG8_STAGE(PG8_SB(1, 0), b3, voffB);
            PG8_BAR; PG8_WAIT_L(0); PG8_MMA(0, 1, At, B1); PG8_BAR;
            PG8_LDA(At, 1, 1); PG8_STAGE(PG8_SA(1, 0), a3, voffA);
            PG8_BAR; PG8_WAIT_L(0); PG8_MMA(1, 0, At, B0); PG8_BAR; PG8_SCHED;
            PG8_STAGE(PG8_SB(1, 1), b3 + hstepB, voffB);
            PG8_WAIT_V(6); PG8_BAR; PG8_MMA(1, 1, At, B1); PG8_BAR;
        }
        E(acc, cur, wr, wc, fr, fq);
        if (!has_next) break;
#pragma unroll
        for (int a = 0; a < 2; ++a)
#pragma unroll
            for (int b = 0; b < 2; ++b)
#pragma unroll
                for (int m = 0; m < 4; ++m)
#pragma unroll
                    for (int n = 0; n < 2; ++n) acc[a][b][m][n] = (f32x4){0.f, 0.f, 0.f, 0.f};
        cur = nxt; cA = nA; cB = nB; ++ui;
    }
    PG8_WAIT_V(0);
    if (wr == 0) PG8_BAR;
    PG8_BAR;
#undef PG8_ABASE
#undef PG8_BBASE
#undef PG8_SA
#undef PG8_SB
#undef PG8_STAGE
#undef PG8_LDA
#undef PG8_LDB
#undef PG8_MMA
#undef PG8_WAIT_V
#undef PG8_WAIT_L
#undef PG8_BAR
#undef PG8_SCHED
}
}

typedef const f32x4 (&AccRef)[2][2][4][2];
#define EPI_LOOP_BEGIN \
    const int row0 = u.pm * 256 + wr * 64 + fr; const int colu = u.pn * 256 + wc * 32 + 8 * fq; \
    _Pragma("unroll") for (int ai = 0; ai < 2; ++ai) _Pragma("unroll") for (int m = 0; m < 4; ++m) { const int r = row0 + ai * 128 + m * 16; \
    _Pragma("unroll") for (int bj = 0; bj < 2; ++bj) { const int c = colu + bj * 128; float v[8]; \
        v[0] = acc[ai][bj][m][0][0]; v[1] = acc[ai][bj][m][0][1]; v[2] = acc[ai][bj][m][0][2]; v[3] = acc[ai][bj][m][0][3]; \
        v[4] = acc[ai][bj][m][1][0]; v[5] = acc[ai][bj][m][1][1]; v[6] = acc[ai][bj][m][1][2]; v[7] = acc[ai][bj][m][1][3];
#define EPI_LOOP_END } }

struct EpiA {
    bf16_t* P; bf16_t* vall; int lgL, Lm1, b0, koff, col_off;
    DEVI void operator()(AccRef acc, const pg8::Unit& u, int wr, int wc, int fr, int fq) const {
        const int colt = u.pn * 256 + col_off;
        EPI_LOOP_BEGIN
            const int cc = c + col_off;
            if (colt >= C_V && colt < C_HY) { const size_t kvrow = (size_t)(b0 + (r >> lgL)) * KVLEN + koff + (r & Lm1); *(u32x4*)(vall + kvrow * 256 + (cc - C_V)) = pack8(v); }
            else { if (colt >= C_GATE) {
#pragma unroll
                    for (int i = 0; i < 8; ++i) v[i] = sigmoidf_(v[i]); }
                *(u32x4*)(P + (size_t)r * INW + cc) = pack8(v); }
        EPI_LOOP_END
    }
};
struct EpiMerge {
    const bf16_t* P; bf16_t* mg;
    DEVI void operator()(AccRef acc, const pg8::Unit& u, int wr, int wc, int fr, int fq) const {
        const bf16_t* gate = P + C_GATE + u.seg * DM; const bool first = (u.seg == 0);
        EPI_LOOP_BEGIN
            float gv[8]; ld8bf(gate + (size_t)r * INW + c, gv);
            bf16_t* mp = mg + (size_t)r * DM + c;
            float t[8];
            if (first) {
#pragma unroll
                for (int i = 0; i < 8; ++i) t[i] = gv[i] * v[i]; }
            else { float a[8]; ld8bf(mp, a);
#pragma unroll
                for (int i = 0; i < 8; ++i) t[i] = a[i] + gv[i] * v[i]; }
            *(u32x4*)mp = pack8(t);
        EPI_LOOP_END
    }
};
struct EpiRes {
    const float* xl; const float* gmod; float* Y; int lgL, b0, isctx;
    DEVI void operator()(AccRef acc, const pg8::Unit& u, int wr, int wc, int fr, int fq) const {
        EPI_LOOP_BEGIN
            const int mi = isctx ? 8 : b0 + (r >> lgL);
            const float* gp = gmod + (size_t)mi * 6144 + c; const float* xp = xl + (size_t)r * DM + c; float* yp = Y + (size_t)r * DM + c;
            const f32x4 g0 = *(const f32x4*)gp, g1 = *(const f32x4*)(gp + 4), x0 = *(const f32x4*)xp, x1 = *(const f32x4*)(xp + 4);
            *(f32x4*)yp = (f32x4){DN_ALPHA * x0[0] + g0[0] * v[0], DN_ALPHA * x0[1] + g0[1] * v[1], DN_ALPHA * x0[2] + g0[2] * v[2], DN_ALPHA * x0[3] + g0[3] * v[3]};
            *(f32x4*)(yp + 4) = (f32x4){DN_ALPHA * x1[0] + g1[0] * v[4], DN_ALPHA * x1[1] + g1[1] * v[5], DN_ALPHA * x1[2] + g1[2] * v[6], DN_ALPHA * x1[3] + g1[3] * v[7]};
        EPI_LOOP_END
    }
};
struct EpiF1 {
    bf16_t* G;
    DEVI void operator()(AccRef acc, const pg8::Unit& u, int wr, int wc, int fr, int fq) const {
        EPI_LOOP_BEGIN
            float o[4];
#pragma unroll
            for (int i = 0; i < 4; ++i) o[i] = v[i] * sigmoidf_(v[i]) * v[4 + i];
            u32x2 w; w.x = cvt_pk_bf16(o[0], o[1]); w.y = cvt_pk_bf16(o[2], o[3]);
            *(u32x2*)(G + (size_t)r * DFF + (c >> 1)) = w;
        EPI_LOOP_END
    }
};

namespace att {
constexpr int D = 128, NW = 8, QBLK = 32, KVBLK = 64;
constexpr float SCALE = 0.088388347648318440f;
constexpr float THR = 8.f;
constexpr size_t SHM_V = KVBLK * D * 2, SHM_K = KVBLK * D * 2, SHM_ATTN = 2 * SHM_V + 2 * SHM_K + NW * 64 * 4;
#define KSWZ(row, colB) ((row) * 256 + ((colB) ^ (((row) & 7) << 4)))
#define SBAR() __builtin_amdgcn_sched_barrier(0)
DEVI int crow(int r, int hi) { return (r & 3) + 8 * (r >> 2) + 4 * hi; }
DEVI void partialSM(f32x16& p0, f32x16& p1, float mnC) {
  if (mnC != 0.f) { for (int r = 0; r < 16; ++r) p0[r] += mnC; for (int r = 0; r < 16; ++r) p1[r] += mnC; }
  for (int r = 0; r < 16; ++r) p0[r] = __builtin_amdgcn_exp2f(p0[r]);
}
DEVI void finishSM(f32x16& p0, f32x16& p1, float& l_reg, bf16x8& pa0, bf16x8& pa1, bf16x8& pa2, bf16x8& pa3) {
  for (int r = 0; r < 16; ++r) p1[r] = __builtin_amdgcn_exp2f(p1[r]);
  float ps = 0; for (int r = 0; r < 16; ++r) ps += p0[r]; for (int r = 0; r < 16; ++r) ps += p1[r];
  { auto rr = __builtin_amdgcn_permlane32_swap(__float_as_uint(ps), __float_as_uint(ps), false, false);
    ps = __uint_as_float(rr[0]) + __uint_as_float(rr[1]); }
  l_reg += ps;
#define PK4(P, BASE, OUT) do { unsigned a0 = cvt_pk_bf16(P[BASE + 0], P[BASE + 1]), a1 = cvt_pk_bf16(P[BASE + 2], P[BASE + 3]);   \
    unsigned b0 = cvt_pk_bf16(P[BASE + 4], P[BASE + 5]), b1 = cvt_pk_bf16(P[BASE + 6], P[BASE + 7]);                              \
    auto r0 = __builtin_amdgcn_permlane32_swap(a0, b0, false, false); auto r1 = __builtin_amdgcn_permlane32_swap(a1, b1, false, false); \
    u32x4 w = {r0[0], r1[0], r0[1], r1[1]}; OUT = *reinterpret_cast<bf16x8*>(&w); } while (0)
  PK4(p0, 0, pa0); PK4(p0, 8, pa1); PK4(p1, 0, pa2); PK4(p1, 8, pa3);
#undef PK4
}
DEVI void qkt(f32x16& p0, f32x16& p1, const bf16_t* Ks, const bf16x8* qr, int r32, int hi) {
  p0 = f32x16{}; p1 = f32x16{};
  for (int d0 = 0; d0 < 8; ++d0) { int cb = (d0 * 16 + hi * 8) * 2;
    bf16x8 b0 = *reinterpret_cast<const bf16x8*>((const char*)Ks + KSWZ(r32, cb));
    bf16x8 b1 = *reinterpret_cast<const bf16x8*>((const char*)Ks + KSWZ(32 + r32, cb));
    p0 = __builtin_amdgcn_mfma_f32_32x32x16_bf16(b0, qr[d0], p0, 0, 0, 0);
    p1 = __builtin_amdgcn_mfma_f32_32x32x16_bf16(b1, qr[d0], p1, 0, 0, 0); }
}
DEVI int v_st(int k, int c) { const int kk = (k & ~0xC) | ((k & 4) << 1) | ((k & 8) >> 1); return ((kk >> 3) * 4 + (c >> 5)) * 512 + ((kk & 7) * 32 + (c & 31)) * 2; }
DEVI int v_rd_base(int lane) { return ((lane & 3) << 3) | (((lane >> 2) & 3) << 6) | (((lane >> 4) & 1) << 5) | (((lane >> 5) & 1) << 8); }
constexpr int v_rd_off(int d0, int ks, int half) { return d0 * 512 + ks * 4096 + half * 2048; }
template <int OFF> DEVI s16x4 tr_read(int vb) {
  s16x4 r; asm volatile("ds_read_b64_tr_b16 %0, %1 offset:%2" : "=&v"(r) : "v"(vb), "i"(OFF) : "memory"); return r;
}
template <int D0> DEVI void pv_one(f32x16& od, int vb, bf16x8 pa0, bf16x8 pa1, bf16x8 pa2, bf16x8 pa3) {
  const s16x4 l0 = tr_read<v_rd_off(D0, 0, 0)>(vb), h0 = tr_read<v_rd_off(D0, 0, 1)>(vb), l1 = tr_read<v_rd_off(D0, 1, 0)>(vb), h1 = tr_read<v_rd_off(D0, 1, 1)>(vb);
  const s16x4 l2 = tr_read<v_rd_off(D0, 2, 0)>(vb), h2 = tr_read<v_rd_off(D0, 2, 1)>(vb), l3 = tr_read<v_rd_off(D0, 3, 0)>(vb), h3 = tr_read<v_rd_off(D0, 3, 1)>(vb);
  asm volatile("s_waitcnt lgkmcnt(0)" ::: "memory"); SBAR();
#define PK(L, H) (bf16x8){L[0], L[1], L[2], L[3], H[0], H[1], H[2], H[3]}
  od = __builtin_amdgcn_mfma_f32_32x32x16_bf16(pa0, PK(l0, h0), od, 0, 0, 0);
  od = __builtin_amdgcn_mfma_f32_32x32x16_bf16(pa1, PK(l1, h1), od, 0, 0, 0);
  od = __builtin_amdgcn_mfma_f32_32x32x16_bf16(pa2, PK(l2, h2), od, 0, 0, 0);
  od = __builtin_amdgcn_mfma_f32_32x32x16_bf16(pa3, PK(l3, h3), od, 0, 0, 0);
#undef PK
}
DEVI void pv_d0(f32x16* o, int vb, bf16x8 pa0, bf16x8 pa1, bf16x8 pa2, bf16x8 pa3) {
  pv_one<0>(o[0], vb, pa0, pa1, pa2, pa3); pv_one<1>(o[1], vb, pa0, pa1, pa2, pa3); pv_one<2>(o[2], vb, pa0, pa1, pa2, pa3); pv_one<3>(o[3], vb, pa0, pa1, pa2, pa3);
}
DEVI void attn_dense_body(const bf16_t* Qb, const bf16_t* Kh, const bf16_t* Vh, bf16_t* Ob, int seq, int ldq, int ldk, int ldo, float mshift, char* lds) {
  const int tid = opq_v(threadIdx.x), wid = tid >> 6, lane = tid & 63, r32 = lane & 31, hi = lane >> 5;
  bf16_t* V_lds = (bf16_t*)lds; bf16_t* K_lds = (bf16_t*)(lds + 2 * SHM_V);
  float* ws = (float*)(lds + 2 * SHM_V + 2 * SHM_K) + wid * 64; float* li_l = ws;
  const float mnC = (mshift * 1.4426950408889634f > 60.f) ? -mshift * 1.4426950408889634f : 0.f; float l_reg = 0; f32x16 o[4] = {}; bf16x8 qr[8];
  const bf16_t* Qw = Qb + (long)(wid * QBLK + r32) * ldq + hi * 8;
#pragma unroll
  for (int d0 = 0; d0 < 8; ++d0) qr[d0] = *reinterpret_cast<const bf16x8*>(Qw + d0 * 16);
  const int sr = tid >> 4, sc = (tid & 15) * 8, vst0 = v_st(sr, sc), vst1 = v_st(32 + sr, sc);
  const int vb0 = (int)(uintptr_t)V_lds + v_rd_base(lane);
  struct { bf16x8 vs0, vs1, ks0, ks1; } sr_[2];
  const unsigned goff0 = (unsigned)(sr * ldk + sc) * 2u, goff1 = (unsigned)((32 + sr) * ldk + sc) * 2u;
#define SLOAD(i, k0) do { const char* vbp_ = (const char*)Vh + (size_t)(k0) * ldk * 2; const char* kbp_ = (const char*)Kh + (size_t)(k0) * ldk * 2; \
    sr_[i].vs0 = *reinterpret_cast<const bf16x8*>(vbp_ + goff0); sr_[i].vs1 = *reinterpret_cast<const bf16x8*>(vbp_ + goff1); \
    sr_[i].ks0 = *reinterpret_cast<const bf16x8*>(kbp_ + goff0); sr_[i].ks1 = *reinterpret_cast<const bf16x8*>(kbp_ + goff1); } while (0)
#define SWRITE(b, i) do { *(bf16x8*)((char*)V_lds + (b) * SHM_V + vst0) = sr_[i].vs0;          \
    *(bf16x8*)((char*)V_lds + (b) * SHM_V + vst1) = sr_[i].vs1; int kc = sc * 2;               \
    *(bf16x8*)((char*)K_lds + (b) * SHM_K + KSWZ(sr, kc)) = sr_[i].ks0;                       \
    *(bf16x8*)((char*)K_lds + (b) * SHM_K + KSWZ(32 + sr, kc)) = sr_[i].ks1; } while (0)
#define SWAIT() do { asm volatile("s_waitcnt vmcnt(4)" ::: "memory"); } while (0)
  f32x16 pA0, pA1, pB0, pB1; bf16x8 pa0, pa1, pa2, pa3; const int NT = seq / KVBLK;
  constexpr int SE = 0, SO = 1;
  SLOAD(SE, 0); asm volatile("s_waitcnt vmcnt(0)" ::: "memory"); SWRITE(0, SE); __syncthreads();
  qkt(pA0, pA1, K_lds, qr, r32, hi); partialSM(pA0, pA1, mnC);
  SLOAD(SO, KVBLK); if (2 < NT) SLOAD(SE, 2 * KVBLK);
  SWAIT(); SWRITE(1, SO); __syncthreads();
  for (int j = 1; j + 1 < NT; j += 2) {
    SBAR(); qkt(pB0, pB1, (bf16_t*)((char*)K_lds + SHM_K), qr, r32, hi);
    finishSM(pA0, pA1, l_reg, pa0, pa1, pa2, pa3); SBAR();
    SLOAD(SO, (j + 2) * KVBLK); SBAR();
    pv_d0(o, vb0, pa0, pa1, pa2, pa3); partialSM(pB0, pB1, mnC);
    __syncthreads(); SWAIT(); SWRITE(0, SE);
    __syncthreads();
    SBAR(); qkt(pA0, pA1, K_lds, qr, r32, hi);
    finishSM(pB0, pB1, l_reg, pa0, pa1, pa2, pa3); SBAR();
    if (j + 3 < NT) SLOAD(SE, (j + 3) * KVBLK); SBAR();
    pv_d0(o, vb0 + (int)SHM_V, pa0, pa1, pa2, pa3); partialSM(pA0, pA1, mnC);
    __syncthreads(); SWAIT(); SWRITE(1, SO);
    __syncthreads();
  }
  SBAR(); qkt(pB0, pB1, (bf16_t*)((char*)K_lds + SHM_K), qr, r32, hi);
  finishSM(pA0, pA1, l_reg, pa0, pa1, pa2, pa3); SBAR();
  pv_d0(o, vb0, pa0, pa1, pa2, pa3); partialSM(pB0, pB1, mnC);
  __syncthreads();
  finishSM(pB0, pB1, l_reg, pa0, pa1, pa2, pa3); SBAR();
  pv_d0(o, vb0 + (int)SHM_V, pa0, pa1, pa2, pa3);
  if (hi == 0) li_l[r32] = l_reg; asm volatile("s_waitcnt lgkmcnt(0)" ::: "memory");
  float rli[16];
#pragma unroll
  for (int r = 0; r < 16; ++r) rli[r] = __builtin_amdgcn_rcpf(li_l[crow(r, hi)]);
  bf16_t* Ow = Ob + (long)(wid * QBLK) * ldo;
#pragma unroll
  for (int r = 0; r < 16; ++r) { int orow = crow(r, hi);
#pragma unroll
    for (int d0 = 0; d0 < 4; ++d0) Ow[(long)orow * ldo + d0 * 32 + r32] = (bf16_t)(cvt_pk_bf16(o[d0][r] * rli[r], 0.f) & 0xffffu); }
  __syncthreads();
#undef SLOAD
#undef SWRITE
#undef SWAIT
}
}

DEVI float2 cmul(float2 a, float2 b) { return make_float2(a.x * b.x - a.y * b.y, a.x * b.y + a.y * b.x); }
DEVI float2 cmulc(float2 a, float2 b) { return make_float2(a.x * b.x + a.y * b.y, a.y * b.x - a.x * b.y); }
DEVI float2 cadd(float2 a, float2 b) { return make_float2(a.x + b.x, a.y + b.y); }
DEVI float2 csub(float2 a, float2 b) { return make_float2(a.x - b.x, a.y - b.y); }
DEVI void fft_tables(float2* tab) {
    const int tid = opq_v(threadIdx.x);
    if (tid < 128) { const int k = tid < 64 ? tid : (tid - 64) * 64; float s, c; sincospif(-(float)k / 8192.f, &s, &c); tab[tid] = make_float2(c, s); }
}
DEVI int sw(int i) { return i ^ ((i >> 5) & 1) ^ (((i >> 6) & 1) * 6) ^ (((i >> 7) & 3) << 3); }
DEVI float2 twid(const float2* tab, int k) { return cmul(tab[k & 63], tab[64 + (k >> 6)]); }
template <int LQ> DEVI void fft_fwd_pass(float2* X, const float2* tab) {
    constexpr int q = 1 << LQ; const int tid = opq_v(threadIdx.x);
#pragma unroll 2
    for (int i = 0; i < 8; ++i) {
        const int g = tid + NTHR * i; const int j = g & (q - 1); const int base = ((g >> LQ) << (LQ + 2)) + j;
        const int a0 = sw(base), a1 = sw(base + q), a2 = sw(base + 2 * q), a3 = sw(base + 3 * q);
        const float2 e0 = X[a0], e1 = X[a1], e2 = X[a2], e3 = X[a3];
        const float2 w1 = twid(tab, j << (12 - LQ)), w2 = cmul(w1, w1);
        const float2 f0 = cadd(e0, e2), f2 = cmul(csub(e0, e2), w1), f1 = cadd(e1, e3), d13 = csub(e1, e3);
        const float2 f3 = cmul(make_float2(d13.y, -d13.x), w1);
        X[a0] = cadd(f0, f1); X[a1] = cmul(csub(f0, f1), w2); X[a2] = cadd(f2, f3); X[a3] = cmul(csub(f2, f3), w2);
    }
    __syncthreads();
}
template <int LQ> DEVI void fft_inv_pass(float2* X, const float2* tab) {
    constexpr int q = 1 << LQ; const int tid = opq_v(threadIdx.x);
#pragma unroll 2
    for (int i = 0; i < 8; ++i) {
        const int g = tid + NTHR * i; const int j = g & (q - 1); const int base = ((g >> LQ) << (LQ + 2)) + j;
        const int a0 = sw(base), a1 = sw(base + q), a2 = sw(base + 2 * q), a3 = sw(base + 3 * q);
        const float2 g0 = X[a0], g1 = X[a1], g2 = X[a2], g3 = X[a3];
        const float2 w1 = twid(tab, j << (12 - LQ)), w2 = cmul(w1, w1);
        const float2 t = cmulc(g1, w2), f0 = cadd(g0, t), f1 = csub(g0, t), t2 = cmulc(g3, w2), f2 = cadd(g2, t2), f3 = csub(g2, t2);
        const float2 uu = cmulc(f2, w1), vv = cmulc(f3, w1), u2 = make_float2(-vv.y, vv.x);
        X[a0] = cadd(f0, uu); X[a2] = csub(f0, uu); X[a1] = cadd(f1, u2); X[a3] = csub(f1, u2);
    }
    __syncthreads();
}
DEVI void r4f(float2& e0, float2& e1, float2& e2, float2& e3, float2 w1, float2 w2) {
    const float2 f0 = cadd(e0, e2), f2 = cmul(csub(e0, e2), w1), f1 = cadd(e1, e3), d13 = csub(e1, e3);
    const float2 f3 = cmul(make_float2(d13.y, -d13.x), w1);
    e0 = cadd(f0, f1); e1 = cmul(csub(f0, f1), w2); e2 = cadd(f2, f3); e3 = cmul(csub(f2, f3), w2);
}
DEVI void r4i(float2& g0, float2& g1, float2& g2, float2& g3, float2 w1, float2 w2) {
    const float2 t = cmulc(g1, w2), f0 = cadd(g0, t), f1 = csub(g0, t), t2 = cmulc(g3, w2), f2 = cadd(g2, t2), f3 = csub(g2, t2);
    const float2 uu = cmulc(f2, w1), vv = cmulc(f3, w1), u2 = make_float2(-vv.y, vv.x);
    g0 = cadd(f0, uu); g2 = csub(f0, uu); g1 = cadd(f1, u2); g3 = csub(f1, u2);
}
template <int LQ> DEVI int r16_sb(int base) {
    if (LQ == 10) return sw(base);
    if (LQ == 6) return base ^ ((base >> 5) & 1);
    return base ^ ((((base >> 6) & 1) * 6) ^ (((base >> 7) & 3) << 3));
}
template <int LQ> DEVI int r16_addr(int sb, int e) {
    if (LQ == 10) return sb + e * 1024;
    if (LQ == 6) return (sb ^ (((e & 1) * 6) ^ (((e >> 1) & 3) << 3))) + 64 * e;
    return sb ^ ((4 * e) ^ (e >> 3));
}
template <int LQ, bool INV, int HALF = 0> DEVI void fft_r16_pass(float2* X, const float2* tab) {
    constexpr int q = 1 << LQ; const int tid = opq_v(threadIdx.x);
#pragma unroll 1
    for (int i = 0; i < 2; ++i) {
        const int g = tid + NTHR * i; const int j = g & (q - 1); const int base = ((g >> LQ) << (LQ + 4)) + j;
        float2 x[16]; const int sb = r16_sb<LQ>(base);
#pragma unroll
        for (int e = 0; e < 16; ++e) x[e] = (HALF == 1 && e >= 8) ? make_float2(0.f, 0.f) : X[r16_addr<LQ>(sb, e)];
        const float2 wb = twid(tab, j << (10 - LQ));
        float2 w[4]; w[0] = wb; w[1] = cmul(wb, make_float2(0.92387953251128674f, -0.38268343236508977f)); w[2] = cmul(wb, make_float2(0.70710678118654752f, -0.70710678118654752f));
        w[3] = cmul(wb, make_float2(0.38268343236508977f, -0.92387953251128674f));
        const float2 wb2 = cmul(wb, wb), w4 = cmul(wb2, wb2), w8 = cmul(w4, w4);
        if (!INV) {
#pragma unroll
            for (int e = 0; e < 4; ++e) r4f(x[e], x[e + 4], x[e + 8], x[e + 12], w[e], cmul(w[e], w[e]));
#pragma unroll
            for (int m = 0; m < 4; ++m) r4f(x[4 * m], x[4 * m + 1], x[4 * m + 2], x[4 * m + 3], w4, w8);
        } else {
#pragma unroll
            for (int m = 0; m < 4; ++m) r4i(x[4 * m], x[4 * m + 1], x[4 * m + 2], x[4 * m + 3], w4, w8);
#pragma unroll
            for (int e = 0; e < 4; ++e) r4i(x[e], x[e + 4], x[e + 8], x[e + 12], w[e], cmul(w[e], w[e]));
        }
#pragma unroll
        for (int e = 0; e < 16; ++e) if (!(HALF == 2 && e >= 8)) X[r16_addr<LQ>(sb, e)] = x[e];
    }
    __syncthreads();
}
DEVI void fft_mid_mul(float2* X, const unsigned* kfc) {
    const int tid = opq_v(threadIdx.x);
#pragma unroll 1
    for (int ib = 0; ib < 8; ib += 4) {
        u32x4 kq[4];
#pragma unroll
        for (int u = 0; u < 4; ++u) { const int base = (tid + NTHR * (ib + u)) * 4; kq[u] = *(const u32x4*)(kfc + base); }
#pragma unroll
        for (int u = 0; u < 4; ++u) {
            const int base = (tid + NTHR * (ib + u)) * 4;
            const int a0 = sw(base), a1 = sw(base + 1), a2 = sw(base + 2), a3 = sw(base + 3);
            const float2 e0 = X[a0], e1 = X[a1], e2 = X[a2], e3 = X[a3];
            const float2 f0 = cadd(e0, e2), f2 = csub(e0, e2), f1 = cadd(e1, e3), d13 = csub(e1, e3), f3 = make_float2(d13.y, -d13.x);
#define KFC(w) make_float2(__uint_as_float((w) << 16), __uint_as_float((w) & 0xffff0000u))
            const float2 g0 = cmul(cadd(f0, f1), KFC(kq[u][0])), g1 = cmul(csub(f0, f1), KFC(kq[u][1]));
            const float2 g2 = cmul(cadd(f2, f3), KFC(kq[u][2])), g3 = cmul(csub(f2, f3), KFC(kq[u][3]));
#undef KFC
            const float2 h0 = cadd(g0, g1), h1 = csub(g0, g1), h2 = cadd(g2, g3), h3 = csub(g2, g3), u2 = make_float2(-h3.y, h3.x);
            X[a0] = cadd(h0, h2); X[a2] = csub(h0, h2); X[a1] = cadd(h1, u2); X[a3] = csub(h1, u2);
        }
    }
    __syncthreads();
}
DEVI void fft_fwd(float2* X, const float2* tab) { fft_r16_pass<10, false>(X, tab); fft_r16_pass<6, false>(X, tab); fft_r16_pass<2, false>(X, tab); fft_fwd_pass<0>(X, tab); }
DEVI void fft_inv(float2* X, const float2* tab) { fft_inv_pass<0>(X, tab); fft_r16_pass<2, true>(X, tab); fft_r16_pass<6, true>(X, tab); fft_r16_pass<10, true>(X, tab); }

DEVI float block_sum(float v, float* red) {
    v = wave_sum(v); const int tid = opq_v(threadIdx.x);
    __syncthreads();
    if ((tid & 63) == 0) red[tid >> 6] = v;
    __syncthreads();
    float s = 0.f;
#pragma unroll
    for (int i = 0; i < 8; ++i) s += red[i];
    return s;
}

template <int MAP> DEVI void wt_transpose(const float* src, int K, int N, bf16_t* dst, float* lds, int bid, int nb) {
    const int tid = opq_v(threadIdx.x), ntn = N / 256, ntiles = (K / 64) * ntn;
    for (int tile = bid; tile < ntiles; tile += nb) {
        const int k0 = (tile / ntn) * 64, n0 = (tile % ntn) * 256;
        __syncthreads();
        f32x4 v[8];
#pragma unroll
        for (int ps = 0; ps < 8; ++ps) v[ps] = *(const f32x4*)(src + (size_t)(k0 + (tid >> 6) + 8 * ps) * N + n0 + (tid & 63) * 4);
#pragma unroll
        for (int ps = 0; ps < 8; ++ps) { const int kk = (tid >> 6) + 8 * ps, nn = (tid & 63) * 4;
            lds[kk * 257 + nn] = v[ps][0]; lds[kk * 257 + nn + 1] = v[ps][1]; lds[kk * 257 + nn + 2] = v[ps][2]; lds[kk * 257 + nn + 3] = v[ps][3]; }
        __syncthreads();
#pragma unroll
        for (int ps = 0; ps < 4; ++ps) { const int nn = (tid >> 3) + 64 * ps, k8 = (tid & 7) * 8; float o[8];
#pragma unroll
            for (int i = 0; i < 8; ++i) o[i] = lds[(k8 + i) * 257 + nn];
            const int n = n0 + nn; const int nd = MAP == 0 ? n : (8 * (n >> 2) + (n & 3) + (MAP == 2 ? 4 : 0));
            *(u32x4*)(dst + (size_t)nd * K + k0 + k8) = pack8(o); }
    }
}
DEVI void wpc_job(const float* pool_w, const float* pool_s, const float* wb2, bf16_t* dst, float* lds, int bid, int nb) {
    const int tid = opq_v(threadIdx.x);
    float* sa = lds;
    float* sb = lds + 64 * 257;
    for (int tile = bid; tile < 256; tile += nb) {
        const int g = tile >> 6, c0 = ((tile >> 4) & 3) * 64, e0 = (tile & 15) * 64;
        __syncthreads();
        for (int idx = tid; idx < 64 * 256; idx += NTHR) { const int cc = idx >> 8, d = idx & 255; sa[cc * 257 + d] = pool_w[((size_t)g * 256 + c0 + cc) * 256 + d]; }
        for (int idx = tid; idx < 256 * 64; idx += NTHR) { const int d = idx >> 6, ee = idx & 63; sb[d * 65 + ee] = pool_s[g * 256 + d] * wb2[(size_t)(g * 256 + d) * DM + e0 + ee]; }
        __syncthreads();
        const int ee = tid >> 3, c8 = (tid & 7) * 8; float acc[8];
#pragma unroll
        for (int i = 0; i < 8; ++i) acc[i] = 0.f;
        for (int d = 0; d < 256; ++d) { const float b = sb[d * 65 + ee];
#pragma unroll
            for (int i = 0; i < 8; ++i) acc[i] += sa[(c8 + i) * 257 + d] * b; }
        *(u32x4*)(dst + (size_t)(e0 + ee) * DM + g * 256 + c0 + c8) = pack8(acc);
    }
}
DEVI void modp_job(const Params& p, float* modp, float* lds, int bid, int nb) {
    const int tid = opq_v(threadIdx.x);
    for (int unit = bid; unit < 2 * 16 * 12; unit += nb) {
        const int l = unit / 192, ks = (unit / 12) % 16, jb = unit % 12, j = jb * 512 + tid;
        __syncthreads();
        for (int idx = tid; idx < 9 * 64; idx += NTHR) { const int m = idx >> 6, kk = idx & 63; const float cv = m < 8 ? p.in[I_C][m * DM + ks * 64 + kk] : p.in[I_CCTX][ks * 64 + kk];
            lds[idx] = cv * sigmoidf_(cv); }
        __syncthreads();
        float acc[9];
#pragma unroll
        for (int m = 0; m < 9; ++m) acc[m] = 0.f;
        const float* w = p.in[I_WADA] + ((size_t)l * DM + ks * 64) * 6144 + j;
        for (int kk = 0; kk < 64; ++kk) { const float wv = w[(size_t)kk * 6144];
#pragma unroll
            for (int m = 0; m < 9; ++m) acc[m] += lds[m * 64 + kk] * wv; }
#pragma unroll
        for (int m = 0; m < 9; ++m) modp[(((size_t)l * 16 + ks) * 9 + m) * 6144 + j] = acc[m];
    }
}
DEVI void gen_filter(const Params& p, int l, int L, int mode, float* dst, float* lds, int bid, int nb) {
    const int tid = opq_v(threadIdx.x);
    float* feats = lds;
    float* h1 = lds + 32 * 33;
    float* h2 = h1 + 32 * 64;
    const float* w1 = p.in[I_HW1] + (size_t)l * 33 * 64; const float* b1 = p.in[I_HB1] + l * 64; const float* fq = p.in[I_HFREQ] + l * 64;
    const float* w2 = p.in[I_HW2] + (size_t)l * 64 * 64; const float* b2 = p.in[I_HB2] + l * 64; const float* w3 = p.in[I_HW3] + (size_t)l * 64 * 2048;
    const float inv_lm1 = 1.f / (float)(L - 1);
    for (int unit = bid; unit < L / 32; unit += nb) {
        const int t0 = unit * 32;
        __syncthreads();
        for (int idx = tid; idx < 32 * 33; idx += NTHR) { const int tt = idx / 33, f = idx % 33; const float tf = (float)(t0 + tt); float v;
            if (f == 0) v = tf * inv_lm1;
            else { const int bi = (f - 1) & 15; const float band = 1e-4f + (float)bi * ((15.f - 1e-4f) / 15.f); const float ang = (6.283185307179586f / (float)L) * tf * band; v = f <= 16 ? cosf(ang) : -sinf(ang); }
            feats[idx] = v; }
        __syncthreads();
#pragma unroll 1
        for (int k = 0; k < 4; ++k) { const int idx = tid + NTHR * k, tt = idx >> 6, j = idx & 63; float a = b1[j];
#pragma unroll 3
            for (int f = 0; f < 33; ++f) a += feats[tt * 33 + f] * w1[f * 64 + j];
            h1[idx] = sinf(fq[j] * a); }
        __syncthreads();
#pragma unroll 1
        for (int k = 0; k < 4; ++k) { const int idx = tid + NTHR * k, tt = idx >> 6, j = idx & 63; float a = b2[j];
#pragma unroll 8
            for (int i = 0; i < 64; ++i) a += h1[tt * 64 + i] * w2[i * 64 + j];
            h2[idx] = sinf(fq[j] * a); }
        __syncthreads();
        { const int wid = tid >> 6, lane = tid & 63, m = lane & 31, hi = lane >> 5;
          bf16x8 af[4];
#pragma unroll
          for (int kk = 0; kk < 4; ++kk) { float hv[8];
#pragma unroll
              for (int j = 0; j < 8; ++j) hv[j] = h2[m * 64 + 16 * kk + hi * 8 + j];
              const u32x4 pk = pack8(hv); af[kk] = *reinterpret_cast<const bf16x8*>(&pk); }
          const float dmin = -3.0701134573253946f, dmax = -15.350567286626973f;
#pragma unroll 1
          for (int tl = wid; tl < 64; tl += 8) {
              const int o = tl * 32 + m, isb = tl >> 5;
              f32x16 acc = {};
#pragma unroll
              for (int kk = 0; kk < 4; ++kk) { float wv[8];
#pragma unroll
                  for (int j = 0; j < 8; ++j) wv[j] = w3[(size_t)(16 * kk + hi * 8 + j) * 2048 + o];
                  const u32x4 pk = pack8(wv);
                  acc = __builtin_amdgcn_mfma_f32_32x32x16_bf16(*reinterpret_cast<const bf16x8*>(&pk), af[kk], acc, 0, 0, 0); }
              const int t = t0 + m; const float t01 = (float)t * inv_lm1;
#pragma unroll
              for (int r = 0; r < 16; ++r) { const int c = (tl * 32 + (r & 3) + 8 * (r >> 2) + 4 * hi) & 1023;
                  const float delta = fabsf(dmin + (float)c * ((dmax - dmin) / 1023.f)); const float val = acc[r] * (__expf(-t01 * delta) + 0.05f);
                  if (mode == 0) { if (!isb) dst[(size_t)c * FFTN + t] = val; else if (t > 0) dst[(size_t)c * FFTN + FFTN - t] = val; else dst[(size_t)c * FFTN + SEQ] = 0.f; }
                  else { if (!isb) dst[c * 512 + 256 + t] = val; else if (t > 0) dst[c * 512 + 256 - t] = val; else dst[c * 512] = 0.f; }
              }
          }
        }
    }
}
DEVI void kf_job(const float* kt, const float* hyd, unsigned* kf, char* ldsc, int bid, int nb) {
    const int tid = opq_v(threadIdx.x); float2* X = (float2*)ldsc; float2* tab = (float2*)(ldsc + FFTN * 8); float* red = (float*)(tab + 128);
    __syncthreads(); fft_tables(tab); __syncthreads();
    for (int u = bid; u < 512; u += nb) {
        const int c0 = 2 * u, c1 = c0 + 1;
        float ss0 = 0.f, ss1 = 0.f;
#pragma unroll 2
        for (int i = 0; i < 8; ++i) { const int t4 = (tid + NTHR * i) * 4; const f32x4 va = *(const f32x4*)(kt + (size_t)c0 * FFTN + t4), vb = *(const f32x4*)(kt + (size_t)c1 * FFTN + t4);
            ss0 += va[0] * va[0] + va[1] * va[1] + va[2] * va[2] + va[3] * va[3]; ss1 += vb[0] * vb[0] + vb[1] * vb[1] + vb[2] * vb[2] + vb[3] * vb[3];
            X[sw(t4)] = make_float2(va[0], vb[0]); X[sw(t4 + 1)] = make_float2(va[1], vb[1]); X[sw(t4 + 2)] = make_float2(va[2], vb[2]); X[sw(t4 + 3)] = make_float2(va[3], vb[3]); }
        const float tot0 = block_sum(ss0, red); const float tot1 = block_sum(ss1, red);
        const float sc0 = 0.5f * rsqrtf(tot0 + EPSF) * (1.f / FFTN), sc1 = 0.5f * rsqrtf(tot1 + EPSF) * (1.f / FFTN); const float dd0 = hyd[c0] * (1.f / FFTN), dd1 = hyd[c1] * (1.f / FFTN);
        fft_fwd(X, tab);
#pragma unroll 4
        for (int i = 0; i < 32; ++i) { const int pp = tid + NTHR * i; const int k = (int)(__brev((unsigned)pp) >> 18); const int pq = (int)(__brev((unsigned)((FFTN - k) & (FFTN - 1))) >> 18);
            const float2 xp = X[sw(pp)], xq = X[sw(pq)];
            kf[(size_t)c0 * FFTN + pp] = cvt_pk_bf16((xp.x + xq.x) * sc0 + dd0, (xp.y - xq.y) * sc0);
            kf[(size_t)c1 * FFTN + pp] = cvt_pk_bf16((xp.y + xq.y) * sc1 + dd1, (xq.x - xp.x) * sc1); }
        __syncthreads();
    }
}
DEVI void fftconv_job(const bf16_t* zt, bf16_t* zo, const unsigned* kf, char* ldsc, int bid, int nb) {
    const int tid = opq_v(threadIdx.x); float2* X = (float2*)ldsc; float2* tab = (float2*)(ldsc + FFTN * 8);
    __syncthreads(); fft_tables(tab); __syncthreads();
    for (int c = bid; c < 1024; c += nb) {
        const bf16_t* z0 = zt + (size_t)c * SEQ; const bf16_t* z1 = zt + (size_t)(1024 + c) * SEQ;
#pragma unroll
        for (int i = 0; i < 2; ++i) { const int t8 = (tid + NTHR * i) * 8; float a[8], b[8]; ld8bf(z0 + t8, a); ld8bf(z1 + t8, b);
#pragma unroll
            for (int e = 0; e < 8; ++e) X[sw(t8 + e)] = make_float2(a[e], b[e]); }
        __syncthreads();
        fft_r16_pass<10, false, 1>(X, tab); fft_r16_pass<6, false>(X, tab); fft_r16_pass<2, false>(X, tab);
        fft_mid_mul(X, kf + (size_t)c * FFTN);
        fft_r16_pass<2, true>(X, tab); fft_r16_pass<6, true>(X, tab); fft_r16_pass<10, true, 2>(X, tab);
#pragma unroll
        for (int i = 0; i < 2; ++i) { const int t8 = (tid + NTHR * i) * 8; float a[8], b[8];
#pragma unroll
            for (int e = 0; e < 8; ++e) { const float2 v = X[sw(t8 + e)]; a[e] = v.x; b[e] = v.y; }
            *(u32x4*)(zo + (size_t)c * SEQ + t8) = pack8(a); *(u32x4*)(zo + (size_t)(1024 + c) * SEQ + t8) = pack8(b); }
        __syncthreads();
    }
}
DEVI void ctxconv_job(bf16_t* zt, const float* kc, const float* hyd, float* lds, int bid, int nb) {
    const int tid = opq_v(threadIdx.x); float* zs = lds; float* ks = lds + 256; float* red = lds + 768;
    for (int unit = bid; unit < NBATCH * 1024; unit += nb) {
        const int c = unit & 1023; bf16_t* z = zt + (size_t)unit * 256;
        __syncthreads();
        const float kv = kc[c * 512 + tid]; ks[tid] = kv; if (tid < 256) zs[tid] = bf2f(z[tid]);
        const float tot = block_sum(kv * kv, red);
        const float nrm = rsqrtf(tot + EPSF);
        if (tid < 256) { float a = 0.f;
            for (int s = 0; s < 256; ++s) a += ks[256 + tid - s] * zs[s];
            z[tid] = (bf16_t)(cvt_pk_bf16(a * nrm + hyd[c] * zs[tid], 0.f) & 0xffffu); }
    }
    __syncthreads();
}

DEVI void headfix_job(const Params& p, const Chunk& ch, int l, int full, int bid, int nb) {
    const int tid = opq_v(threadIdx.x), li = tid & 15, grp = tid >> 4;
    bf16_t* P = (bf16_t*)(p.ws + OFF_P); bf16_t* kall = (bf16_t*)(p.ws + OFF_KALL);
    const float2* rope = (const float2*)(p.ws + OFF_ROPE);
    const int nh = full ? 10 : 2, npairs = ch.nrows * nh;
#pragma unroll 2
    for (int pb = bid * 32; pb < npairs; pb += nb * 32) {
        const int pi = pb + grp; const int r = pi / nh, hh = pi % nh + (full ? 0 : 8);
        float x[8]; ld8bf(P + (size_t)r * INW + hh * 128 + li * 8, x);
        float ss = 0.f;
#pragma unroll
        for (int i = 0; i < 8; ++i) ss += x[i] * x[i];
        ss += __shfl_xor(ss, 1); ss += __shfl_xor(ss, 2); ss += __shfl_xor(ss, 4); ss += __shfl_xor(ss, 8);
        const float rstd = rsqrtf(ss * (1.f / 128.f) + EPSF);
        const float* gw = (hh < 8 ? p.in[I_QG] : p.in[I_KG]) + l * 128 + li * 8;
        float y[8];
#pragma unroll
        for (int i = 0; i < 8; ++i) y[i] = x[i] * rstd * gw[i];
        if (!ch.isctx) {
            const int t = r & (SEQ - 1); const int pos = (li < 8) ? (t >> 6) : (t & 63); const int f0 = 8 * (li & 3);
#pragma unroll
            for (int i = 0; i < 8; ++i) { const float yp = __shfl_xor(y[i], 4); const float2 cs = rope[pos * 32 + f0 + i];
                y[i] = (li & 4) ? (y[i] * cs.x + yp * cs.y) : (y[i] * cs.x - yp * cs.y); }
        }
        if (hh < 8) {
#pragma unroll
            for (int i = 0; i < 8; ++i) y[i] *= 0.12751743082459868f; }
        const u32x4 w = pack8(y);
        if (hh < 8) *(u32x4*)(P + (size_t)r * INW + hh * 128 + li * 8) = w;
        else { const size_t kvrow = (size_t)(ch.b0 + (r >> ch.lgL)) * KVLEN + ch.koff + (r & (ch.L - 1)); *(u32x4*)(kall + kvrow * 256 + (hh - 8) * 128 + li * 8) = w; }
    }
}
DEVI void conv3x8(const bf16_t* P, int r, int t, int L, int colP, const float* cw, const float* cb, int colW, float* s) {
    float u0[8], u1[8], u2[8];
    ld8bf(P + (size_t)r * INW + colP, u1);
    if (t > 0) ld8bf(P + (size_t)(r - 1) * INW + colP, u0); else {
#pragma unroll
        for (int i = 0; i < 8; ++i) u0[i] = 0.f; }
    if (t < L - 1) ld8bf(P + (size_t)(r + 1) * INW + colP, u2); else {
#pragma unroll
        for (int i = 0; i < 8; ++i) u2[i] = 0.f; }
#pragma unroll
    for (int i = 0; i < 8; ++i) s[i] = cb[colW + i] + cw[colW + i] * u0[i] + cw[3072 + colW + i] * u1[i] + cw[6144 + colW + i] * u2[i];
}
DEVI void hypre_job(const Params& p, const Chunk& ch, int l, float* lds, int bid, int nb) {
    const int tid = opq_v(threadIdx.x); const bf16_t* P = (const bf16_t*)(p.ws + OFF_P); bf16_t* zt = (bf16_t*)(p.ws + OFF_ZT);
    const float* cw = p.in[I_HCW] + (size_t)l * 3 * 3072; const float* cb = p.in[I_HCB] + (size_t)l * 3072;
    const int ntiles = (ch.nrows / 64) * 8;
    for (int tile = bid; tile < ntiles; tile += nb) {
        const int r0 = (tile >> 3) * 64, c0 = (tile & 7) * 128, s = r0 >> ch.lgL, t0 = r0 & (ch.L - 1);
        __syncthreads();
#pragma unroll
        for (int k = 0; k < 2; ++k) { const int task = tid + NTHR * k, tt = task >> 4, cg8 = (task & 15) * 8, c = c0 + cg8;
            float sv[8], sx[8];
            conv3x8(P, r0 + tt, t0 + tt, ch.L, C_HY + c, cw, cb, c, sv);
            conv3x8(P, r0 + tt, t0 + tt, ch.L, C_HY + 2048 + c, cw, cb, 2048 + c, sx);
#pragma unroll
            for (int i = 0; i < 8; ++i) lds[(cg8 + i) * 65 + tt] = sv[i] * sx[i]; }
        __syncthreads();
#pragma unroll
        for (int k = 0; k < 2; ++k) { const int idx = tid + NTHR * k, row = idx >> 3, q8 = (idx & 7) * 8; float v[8];
#pragma unroll
            for (int e = 0; e < 8; ++e) v[e] = lds[row * 65 + q8 + e];
            *(u32x4*)(zt + ((size_t)(s * 1024 + c0 + row)) * ch.L + t0 + q8) = pack8(v); }
    }
}
DEVI void hypost_job(const Params& p, const Chunk& ch, int l, float* lds, int bid, int nb) {
    const int tid = opq_v(threadIdx.x); bf16_t* P = (bf16_t*)(p.ws + OFF_P); const bf16_t* zt = (const bf16_t*)(p.ws + OFF_ZT);
    const float* cw = p.in[I_HCW] + (size_t)l * 3 * 3072; const float* cb = p.in[I_HCB] + (size_t)l * 3072;
    const int ntiles = (ch.nrows / 64) * 8;
    for (int tile = bid; tile < ntiles; tile += nb) {
        const int r0 = (tile >> 3) * 64, c0 = (tile & 7) * 128, s = r0 >> ch.lgL, t0 = r0 & (ch.L - 1);
        __syncthreads();
#pragma unroll
        for (int k = 0; k < 2; ++k) { const int idx = tid + NTHR * k, row = idx >> 3, q8 = (idx & 7) * 8; float v[8];
            ld8bf(zt + ((size_t)(s * 1024 + c0 + row)) * ch.L + t0 + q8, v);
#pragma unroll
            for (int e = 0; e < 8; ++e) lds[row * 65 + q8 + e] = v[e]; }
        __syncthreads();
#pragma unroll
        for (int k = 0; k < 2; ++k) { const int task = tid + NTHR * k, tt = task >> 4, cg8 = (task & 15) * 8, c = c0 + cg8;
            float sx[8], o[8];
            conv3x8(P, r0 + tt, t0 + tt, ch.L, C_HY + 1024 + c, cw, cb, 1024 + c, sx);
#pragma unroll
            for (int i = 0; i < 8; ++i) o[i] = sx[i] * lds[(cg8 + i) * 65 + tt];
            *(u32x4*)(P + (size_t)(r0 + tt) * INW + C_HY + c) = pack8(o); }
    }
}
DEVI void poolpre_job(const Params& p, const Chunk& ch, int bid, int nb) {
    const int tid = opq_v(threadIdx.x); bf16_t* P = (bf16_t*)(p.ws + OFF_P);
    const int ntask = (ch.nrows / 16) * 128, L = ch.L;
    for (int task = bid * NTHR + tid; task < ntask; task += nb * NTHR) {
        const int run = task >> 7, c = (task & 127) * 8, gi = c >> 8, w = 2 << gi, before = w >> 1, after = w - 1 - before;
        const int r0 = run * 16, t0 = r0 & (L - 1), rs = r0 - t0;
        const bf16_t* base = P + (size_t)rs * INW + C_POOL + c;
        float S[8], u[8];
#pragma unroll
        for (int i = 0; i < 8; ++i) S[i] = 0.f;
        { const int lo = max(t0 - before, 0), hi = min(t0 + after, L - 1);
          for (int tt = lo; tt <= hi; ++tt) { ld8bf(base + (size_t)tt * INW, u);
#pragma unroll
              for (int i = 0; i < 8; ++i) S[i] += u[i]; } }
#pragma unroll 4
        for (int k = 0; k < 16; ++k) { const int t = t0 + k; const int lo = max(t - before, 0), hi = min(t + after + 1, L); const float rc = 1.f / (float)(hi - lo);
            ld8bf(base + (size_t)t * INW, u); float o[8];
#pragma unroll
            for (int i = 0; i < 8; ++i) o[i] = S[i] * rc - u[i];
            *(u32x4*)(P + (size_t)(r0 + k) * INW + C_HY + 2048 + c) = pack8(o);
            if (t + 1 + after < L) { ld8bf(base + (size_t)(t + 1 + after) * INW, u);
#pragma unroll
                for (int i = 0; i < 8; ++i) S[i] += u[i]; }
            if (t - before >= 0) { ld8bf(base + (size_t)(t - before) * INW, u);
#pragma unroll
                for (int i = 0; i < 8; ++i) S[i] -= u[i]; }
        }
    }
}
DEVI void ln_job(const Chunk& ch, const float* Y, const float* g, const float* b, float* xl, bf16_t* hdst, const float* mod, int shoff, int scoff, int bid, int nb) {
    const int tid = opq_v(threadIdx.x), wid = tid >> 6, lane = tid & 63;
    for (int r = bid * 8 + wid; r < ch.nrows; r += nb * 8) {
        const float* yp = Y + (size_t)r * DM; f32x4 v[4];
#pragma unroll
        for (int k = 0; k < 4; ++k) v[k] = *(const f32x4*)(yp + k * 256 + lane * 4);
        float s = 0.f;
#pragma unroll
        for (int k = 0; k < 4; ++k) s += v[k][0] + v[k][1] + v[k][2] + v[k][3];
        const float mu = wave_sum(s) * (1.f / DM);
        float q = 0.f;
#pragma unroll
        for (int k = 0; k < 4; ++k) { v[k] = v[k] - mu; q += v[k][0] * v[k][0] + v[k][1] * v[k][1] + v[k][2] * v[k][2] + v[k][3] * v[k][3]; }
        const float rstd = rsqrtf(wave_sum(q) * (1.f / DM) + EPSF);
        const int mi = ch.isctx ? 8 : ch.b0 + (r >> ch.lgL);
#pragma unroll
        for (int k = 0; k < 4; ++k) { const int c = k * 256 + lane * 4; const f32x4 gg = *(const f32x4*)(g + c), bb = *(const f32x4*)(b + c);
            const f32x4 o = v[k] * rstd * gg + bb;
            *(f32x4*)(xl + (size_t)r * DM + c) = o;
            if (hdst) { const f32x4 sc = *(const f32x4*)(mod + (size_t)mi * 6144 + scoff + c), sh = *(const f32x4*)(mod + (size_t)mi * 6144 + shoff + c);
                const f32x4 h = o * (sc + 1.f) + sh; u32x2 w; w.x = cvt_pk_bf16(h[0], h[1]); w.y = cvt_pk_bf16(h[2], h[3]);
                *(u32x2*)(hdst + (size_t)r * DM + c) = w; } }
    }
}

#define XB_TMO      128
#define XB_XCNT(j)  (256  + 64 * (j))
#define XB_XSUB(j)  (1280 + 64 * (j))
#define XB_XGEN(j)  (2304 + 64 * (j))
#define XB_TOP      3328
#define XB_TOPGEN   3392
#define XCD_BAR_WORDS 3456
#define XB_SPIN_CAP (1u << 20)
DEVI unsigned xb_ld(unsigned* p)              { return __hip_atomic_load(p, __ATOMIC_RELAXED, __HIP_MEMORY_SCOPE_AGENT); }
DEVI unsigned xb_add(unsigned* p, unsigned v) { return __hip_atomic_fetch_add(p, v, __ATOMIC_RELAXED, __HIP_MEMORY_SCOPE_AGENT); }
DEVI unsigned xb_xcc_id() { return (unsigned)__builtin_amdgcn_s_getreg((3 << 11) | 20) & 0xFu; }
#define XB_SPIN(cond, bar) do { unsigned _sp = 0; while (cond) { __builtin_amdgcn_s_sleep(1); \
    if ((++_sp & 255u) == 0u) { if (xb_ld(&(bar)[XB_TMO])) break; if (_sp > XB_SPIN_CAP) { atomicAdd(&(bar)[XB_TMO], 1u); break; } } } } while (0)
struct XcdBarrier { unsigned* bar; unsigned x; volatile LAS unsigned* st; };
DEVI XcdBarrier xcd_barrier_post(unsigned* bar, volatile LAS unsigned* st) {
    XcdBarrier b; b.bar = bar; b.x = xb_xcc_id(); b.st = st;
    if (threadIdx.x == 0) (void)xb_add(&bar[XB_XCNT(b.x)], 1u);
    return b;
}
DEVI void xcd_barrier_complete(unsigned* bar, unsigned x, unsigned& nloc, unsigned& nx) {
    const unsigned G = gridDim.x * gridDim.y * gridDim.z;
    unsigned sum, cnt, mine, sp = 0u;
    for (;;) {
        sum = 0u; cnt = 0u; mine = 0u;
#pragma unroll
        for (unsigned j = 0; j < 16; ++j) { const unsigned c = xb_ld(&bar[XB_XCNT(j)]); sum += c; cnt += (c > 0u) ? 1u : 0u; mine = (j == x) ? c : mine; }
        if (sum == G) break;
        __builtin_amdgcn_s_sleep(1);
        if ((++sp & 255u) == 0u) { if (xb_ld(&bar[XB_TMO])) break; if (sp > XB_SPIN_CAP) { atomicAdd(&bar[XB_TMO], 1u); break; } }
    }
    nloc = mine > 0u ? mine : 1u; nx = cnt > 0u ? cnt : 1u;
}
DEVI void xcd_barrier(const XcdBarrier& b) {
    asm volatile("s_waitcnt vmcnt(0)" ::: "memory");
    __syncthreads();
    if (threadIdx.x == 0) {
        unsigned* bar = b.bar;
        __builtin_amdgcn_s_waitcnt(0);
        unsigned nloc = b.st[0], nx = b.st[1];
        if (nloc == 0u) { xcd_barrier_complete(bar, b.x, nloc, nx); b.st[0] = nloc; b.st[1] = nx; }
        const unsigned old = xb_add(&bar[XB_XSUB(b.x)], 1u);
        const unsigned gen = old / nloc;
        if (old + 1u == (gen + 1u) * nloc) {
            __builtin_amdgcn_fence(__ATOMIC_RELEASE, "agent");
            asm volatile("s_waitcnt vmcnt(0)" ::: "memory");
            const unsigned og = xb_add(&bar[XB_TOP], 1u);
            const unsigned tg = og / nx;
            if (og + 1u == (tg + 1u) * nx) xb_add(&bar[XB_TOPGEN], 1u);
            else XB_SPIN(xb_ld(&bar[XB_TOPGEN]) == tg, bar);
            __builtin_amdgcn_fence(__ATOMIC_ACQUIRE, "agent");
            xb_add(&bar[XB_XGEN(b.x)], 1u);
            asm volatile("s_waitcnt vmcnt(0)" ::: "memory");
        } else {
            XB_SPIN(xb_ld(&bar[XB_XGEN(b.x)]) == gen, bar);
            __builtin_amdgcn_fence(__ATOMIC_ACQUIRE, "agent");
            asm volatile("s_waitcnt vmcnt(0)" ::: "memory");
        }
    }
    __syncthreads();
}

__global__ void __launch_bounds__(NTHR, 2) fwd_megakernel(Params p) {
    extern __shared__ __attribute__((aligned(16))) unsigned char lds[];
    cg::grid_group grid = cg::this_grid();
    const int bid = opq_s(blockIdx.x), nb = opq_s(gridDim.x), tid = opq_v(threadIdx.x);
    unsigned char* ws = p.ws;
    float* ldsf = (float*)lds;
    bf16_t* P = (bf16_t*)(ws + OFF_P);
    float* MOD = (float*)(ws + OFF_MOD);
    volatile LAS unsigned* xst = (volatile LAS unsigned*)(LAS unsigned char*)(lds + LDS_BYTES - 16);
    if (tid < 4) xst[tid] = 0u;
    if (bid == 0) for (int i = tid; i < XCD_BAR_WORDS; i += NTHR) __hip_atomic_store((unsigned*)(ws + OFF_BAR) + i, 0u, __ATOMIC_RELAXED, __HIP_MEMORY_SCOPE_AGENT);
    __syncthreads();

    for (int rep = 0; rep < 1 + PROBE_PREP; ++rep) {
    for (int l = 0; l < 2; ++l) {
        wt_transpose<0>(p.in[I_WIN] + (size_t)l * DM * INW, DM, INW, (bf16_t*)(ws + OFF_WIN + l * SZ_WIN), ldsf, bid, nb);
        wt_transpose<0>(p.in[I_WBR] + (size_t)(l * 3 + 0) * DM * DM, DM, DM, (bf16_t*)(ws + OFF_WBR + l * SZ_WBR), ldsf, bid, nb);
        wt_transpose<0>(p.in[I_WBR] + (size_t)(l * 3 + 1) * DM * DM, DM, DM, (bf16_t*)(ws + OFF_WBR + l * SZ_WBR) + (size_t)DM * DM, ldsf, bid, nb);
        wt_transpose<0>(p.in[I_WOUT] + (size_t)l * DM * DM, DM, DM, (bf16_t*)(ws + OFF_WOUT + l * SZ_WOUT), ldsf, bid, nb);
        wt_transpose<1>(p.in[I_FW1] + (size_t)l * DM * DFF, DM, DFF, (bf16_t*)(ws + OFF_W13 + l * SZ_W13), ldsf, bid, nb);
        wt_transpose<2>(p.in[I_FW3] + (size_t)l * DM * DFF, DM, DFF, (bf16_t*)(ws + OFF_W13 + l * SZ_W13), ldsf, bid, nb);
        wt_transpose<0>(p.in[I_FW2] + (size_t)l * DFF * DM, DFF, DM, (bf16_t*)(ws + OFF_W2 + l * SZ_W2), ldsf, bid, nb);
        wpc_job(p.in[I_POOLW] + (size_t)l * 4 * 256 * 256, p.in[I_POOLS] + l * DM, p.in[I_WBR] + (size_t)(l * 3 + 2) * DM * DM,
                (bf16_t*)(ws + OFF_WBR + l * SZ_WBR) + (size_t)2 * DM * DM, ldsf, bid, nb);
    }
    modp_job(p, (float*)(ws + OFF_MODP), ldsf, bid, nb);
    for (int idx = bid * NTHR + tid; idx < 128 * 32; idx += nb * NTHR) { const int pos = idx >> 5, f = idx & 31; const float inv = powf(10000.f, -(float)f / 32.f); float s, c; sincosf((float)pos * inv, &s, &c);
        ((float2*)(ws + OFF_ROPE))[idx] = make_float2(c, s); }
    gen_filter(p, 0, SEQ, 0, (float*)(ws + OFF_P), ldsf, bid, nb);
    gen_filter(p, 1, SEQ, 0, (float*)(ws + OFF_P) + (size_t)1024 * FFTN, ldsf, bid, nb);
    gen_filter(p, 0, CTXL, 1, (float*)(ws + OFF_KC), ldsf, bid, nb);
    }
    grid.sync();
    (void)xcd_barrier_post((unsigned*)(ws + OFF_BAR), xst);
    for (int rep = 0; rep < 1 + PROBE_PREP; ++rep) {
    for (int idx = bid * NTHR + tid; idx < 2 * 9 * 6144; idx += nb * NTHR) { const int l = idx / (9 * 6144), rem = idx % (9 * 6144), j = rem % 6144; float a = p.in[I_BADA][l * 6144 + j];
        for (int ks = 0; ks < 16; ++ks) a += ((const float*)(ws + OFF_MODP))[((size_t)l * 16 + ks) * 9 * 6144 + rem];
        MOD[idx] = a; }
    kf_job((const float*)(ws + OFF_P), p.in[I_HYD], (unsigned*)(ws + OFF_KF), (char*)lds, bid, nb);
    kf_job((const float*)(ws + OFF_P) + (size_t)1024 * FFTN, p.in[I_HYD] + DM, (unsigned*)(ws + OFF_KF + SZ_KF), (char*)lds, bid, nb);
    }
    GSYNC();
    for (int rep = 0; rep < 1 + PROBE_PREP; ++rep) {
    for (size_t i4 = (size_t)bid * NTHR + tid; i4 < (size_t)NTOK * DM / 4; i4 += (size_t)nb * NTHR) {
        const size_t e = i4 * 4; const int r = (int)(e >> 10), c = (int)(e & 1023);
        const bool isc = r >= NLAT; const int mi = isc ? 8 : (r >> 13);
        const f32x4 xv = isc ? *(const f32x4*)(p.in[I_CTX] + (e - (size_t)NLAT * DM)) : *(const f32x4*)(p.in[I_X] + e);
        const f32x4 sh = *(const f32x4*)(MOD + (size_t)mi * 6144 + c), sc = *(const f32x4*)(MOD + (size_t)mi * 6144 + 1024 + c);
        const f32x4 h = xv * (sc + 1.f) + sh; u32x2 w; w.x = cvt_pk_bf16(h[0], h[1]); w.y = cvt_pk_bf16(h[2], h[3]);
        *(u32x2*)((bf16_t*)(ws + OFF_H) + e) = w;
    }
    }
    GSYNC();

    for (int l_ = 0; l_ < 2; ++l_) {
        const int l = opq_s(l_);
        const float* modl = MOD + (size_t)l * 9 * 6144;
        const bf16_t* Wint = (const bf16_t*)(ws + OFF_WIN + l * SZ_WIN);
        const bf16_t* Wbr = (const bf16_t*)(ws + OFF_WBR + l * SZ_WBR);
        for (int grp_ = 0; grp_ < 3; ++grp_) {
            const int grp = opq_s(grp_);
            const int ci_lo = grp == 0 ? -1 : 2 * (grp - 1), ci_hi = grp == 0 ? 0 : ci_lo + 2;
            const int gfull = !(grp == 0 && l == 1);
          for (int ci_ = ci_lo; ci_ < ci_hi; ++ci_) {
            const int ci = opq_s(ci_);
            const Chunk ch = mk_chunk(ci, p);
            const int full = gfull;
            { pg8::Gemm g; g.a0 = g.a1 = g.a2 = 0u; g.bseg = 0; g.A = (const bf16_t*)(ws + OFF_H) + (size_t)ch.row0g * DM; g.lda = DM; g.K = DM; g.M = ch.nrows;
              EpiA E; E.P = P; E.vall = (bf16_t*)(ws + OFF_VALL); E.lgL = ch.lgL; E.Lm1 = ch.L - 1; E.b0 = ch.b0; E.koff = ch.koff;
              if (full) { g.Bt = Wint; g.N = INW; E.col_off = 0; } else { g.Bt = Wint + (size_t)C_K * DM; g.N = 512; E.col_off = C_K; }
              pg8::StaticOrder S; S.init(g.M, g.N, nb, bid);
              for (int rep = 0; rep < 1 + PROBE_GEMM; ++rep) pg8::gemm_phase<EpiA>((LAS unsigned char*)lds, g, S, E); }
            GSYNC();
            for (int rep = 0; rep < 1 + PROBE_EW; ++rep) {
            headfix_job(p, ch, l, full, bid, nb);
            if (full) hypre_job(p, ch, l, ldsf, bid, nb); }
            GSYNC();
            if (!full) continue;
            { const int nqb = ch.L / 256, nun = (ch.nrows / ch.L) * NHEAD * nqb;
              float gq = 0.f, gk = 0.f;
              for (int i = 0; i < HD; ++i) { gq = fmaxf(gq, fabsf(p.in[I_QG][l * HD + i])); gk = fmaxf(gk, fabsf(p.in[I_KG][l * HD + i])); }
              const float mshift = 11.313708498984761f * gq * gk * 1.02f;
              for (int u = bid; u < nun; u += nb) {
                  int qb = u % nqb, h = (u / nqb) % NHEAD, s = u / (nqb * NHEAD);
                  if (!ch.isctx && nb == 256) {
                      const int xcd = bid & 7, slot = bid >> 3, rnd = u >> 8, g4 = xcd & 3, sub = (xcd >> 2) + 2 * rnd;
                      s = g4 >> 1; h = (g4 & 1) * 4 + sub; qb = slot; }
                  const int b = ch.b0 + s;
                  bf16_t* Qb = P + (size_t)(s * ch.L + qb * 256) * INW + h * HD;
                  const bf16_t* Kh = (const bf16_t*)(ws + OFF_KALL) + (size_t)b * KVLEN * 256 + (h >> 2) * HD;
                  const bf16_t* Vh = (const bf16_t*)(ws + OFF_VALL) + (size_t)b * KVLEN * 256 + (h >> 2) * HD;
                  att::attn_dense_body(Qb, Kh, Vh, Qb, ch.isctx ? CTXL : KVLEN, INW, 256, INW, mshift, (char*)lds);
              } }
            if (ch.isctx) ctxconv_job((bf16_t*)(ws + OFF_ZT), (const float*)(ws + OFF_KC), p.in[I_HYD] + l * DM, ldsf, bid, nb);
            else fftconv_job((const bf16_t*)(ws + OFF_ZT), (bf16_t*)(ws + OFF_ZT), (const unsigned*)(ws + OFF_KF + l * SZ_KF), (char*)lds, bid, nb);
            GSYNC();
            for (int rep = 0; rep < 1 + PROBE_EW; ++rep) { hypost_job(p, ch, l, ldsf, bid, nb); poolpre_job(p, ch, bid, nb); }
            GSYNC();
            { pg8::Gemm g; g.K = DM; g.M = ch.nrows; g.N = DM; g.A = P; g.lda = INW; g.Bt = Wbr; g.a0 = C_HY * 2; g.a1 = C_Q * 2; g.a2 = (C_HY + 2048) * 2; g.bseg = (size_t)DM * DM * 2;
              pg8::StaticOrder S; S.init(g.M, g.N, nb, bid, 3);
              EpiMerge E; E.P = P; E.mg = (bf16_t*)(ws + OFF_R2) + (size_t)(ci < 0 ? 0 : (ci & 1)) * CH_ROWS * DM;
              __syncthreads();
              for (int rep = 0; rep < 1 + PROBE_GEMM; ++rep) pg8::gemm_phase<EpiMerge>((LAS unsigned char*)lds, g, S, E); }
            GSYNC();
          }
            if (!gfull) continue;
            Chunk sc = mk_chunk(ci_lo, p);
            if (grp > 0) sc.nrows = 2 * CH_ROWS;
            bf16_t* H2 = (bf16_t*)(ws + OFF_H) + (size_t)sc.row0g * DM;
            { pg8::Gemm g; g.a0 = g.a1 = g.a2 = 0u; g.bseg = 0; g.A = (const bf16_t*)(ws + OFF_R2); g.lda = DM; g.K = DM; g.M = sc.nrows; g.N = DM; g.Bt = (const bf16_t*)(ws + OFF_WOUT + l * SZ_WOUT);
              pg8::StaticOrder S; S.init(g.M, g.N, nb, bid);
              EpiRes E; E.xl = l == 0 ? (sc.isctx ? p.in[I_CTX] : p.in[I_X] + (size_t)sc.row0g * DM) : sc.xl; E.gmod = modl + 2048; E.Y = sc.xl; E.lgL = sc.lgL; E.b0 = sc.b0; E.isctx = sc.isctx;
              __syncthreads();
              for (int rep = 0; rep < 1 + PROBE_GEMM; ++rep) pg8::gemm_phase<EpiRes>((LAS unsigned char*)lds, g, S, E); }
            GSYNC();
            for (int rep = 0; rep < 1 + PROBE_EW; ++rep) ln_job(sc, sc.xl, p.in[I_LN1G] + l * DM, p.in[I_LN1B] + l * DM, sc.xl, H2, modl, 3072, 4096, bid, nb);
            GSYNC();
            { pg8::Gemm g; g.a0 = g.a1 = g.a2 = 0u; g.bseg = 0; g.A = H2; g.lda = DM; g.K = DM; g.M = sc.nrows; g.N = 2 * DFF; g.Bt = (const bf16_t*)(ws + OFF_W13 + l * SZ_W13);
              pg8::StaticOrder S; S.init(g.M, g.N, nb, bid);
              EpiF1 E; E.G = P;
              for (int rep = 0; rep < 1 + PROBE_GEMM; ++rep) pg8::gemm_phase<EpiF1>((LAS unsigned char*)lds, g, S, E); }
            GSYNC();
            { pg8::Gemm g; g.a0 = g.a1 = g.a2 = 0u; g.bseg = 0; g.A = P; g.lda = DFF; g.K = DFF; g.M = sc.nrows; g.N = DM; g.Bt = (const bf16_t*)(ws + OFF_W2 + l * SZ_W2);
              pg8::StaticOrder S; S.init(g.M, g.N, nb, bid);
              EpiRes E; E.xl = sc.xl; E.gmod = modl + 5120; E.Y = sc.xl; E.lgL = sc.lgL; E.b0 = sc.b0; E.isctx = sc.isctx;
              for (int rep = 0; rep < 1 + PROBE_GEMM; ++rep) pg8::gemm_phase<EpiRes>((LAS unsigned char*)lds, g, S, E); }
            GSYNC();
            for (int rep = 0; rep < 1 + PROBE_EW; ++rep) ln_job(sc, sc.xl, p.in[I_LN2G] + l * DM, p.in[I_LN2B] + l * DM, sc.xl, l == 0 ? H2 : (bf16_t*)nullptr,
                   MOD + (size_t)9 * 6144, 0, 1024, bid, nb);
            if (!(l == 1 && grp == 2)) GSYNC();
        }
    }
}

extern "C" void kernel_launch(void* const* d_in, const int* in_sizes, int n_in, void* d_out, int out_size, void* d_ws, size_t ws_size, hipStream_t stream) {
    static int grid_blocks = 0;
    if (grid_blocks == 0) {
        if (n_in != 29 || out_size != NLAT * DM || ws_size < WS_END) { fprintf(stderr, "kernel_launch: unexpected shapes (n_in %d out %d ws %zu need %zu)\n", n_in, out_size, ws_size, (size_t)WS_END); grid_blocks = -1; return; }
        int dev = 0, cus = 0, per_cu = 0;
        hipGetDevice(&dev);
        hipDeviceGetAttribute(&cus, hipDeviceAttributeMultiprocessorCount, dev);
        if (hipFuncSetAttribute((const void*)fwd_megakernel, hipFuncAttributeMaxDynamicSharedMemorySize, LDS_BYTES) != hipSuccess) { fprintf(stderr, "kernel_launch: hipFuncSetAttribute failed\n"); grid_blocks = -1; return; }
        if (hipOccupancyMaxActiveBlocksPerMultiprocessor(&per_cu, (const void*)fwd_megakernel, NTHR, LDS_BYTES) != hipSuccess || per_cu < 1) { fprintf(stderr, "kernel_launch: occupancy query failed (%d)\n", per_cu); per_cu = 1; (void)hipGetLastError(); }
        grid_blocks = cus * 1;
        (void)per_cu;
    }
    if (grid_blocks < 0) return;
    Params p{};
    for (int i = 0; i < 29; ++i) p.in[i] = (const float*)d_in[i];
    p.out = (float*)d_out; p.ws = (unsigned char*)d_ws;
    void* args[] = {&p};
    hipError_t e = hipLaunchCooperativeKernel((const void*)fwd_megakernel, dim3(grid_blocks), dim3(NTHR), args, LDS_BYTES, stream);
    if (e != hipSuccess) fprintf(stderr, "cooperative launch failed: %s (grid %d)\n", hipGetErrorString(e), grid_blocks);
}
```

```cpp
#include <hip/hip_runtime.h>
#include <hip/hip_cooperative_groups.h>
#include <cstdio>
#include <cstdint>
namespace cg = cooperative_groups;
#ifndef PROBE_SYNC
#define PROBE_SYNC 0
#endif
#ifndef PROBE_FFT
#define PROBE_FFT 0
#endif
#ifndef PROBE_ATT
#define PROBE_ATT 0
#endif
#ifndef PROBE_GEMM
#define PROBE_GEMM 0
#endif
#ifndef PROBE_PREP
#define PROBE_PREP 0
#endif
#ifndef PROBE_EW
#define PROBE_EW 0
#endif
#define GSYNC() do { XcdBarrier xb_; xb_.bar = (unsigned*)(p.ws + OFF_BAR); xb_.x = xb_xcc_id(); xb_.st = (volatile LAS unsigned*)(LAS unsigned char*)(lds + LDS_BYTES - 16); xcd_barrier(xb_); if (PROBE_SYNC) xcd_barrier(xb_); } while (0)

#define DEVI __device__ __forceinline__
#define LAS __attribute__((address_space(3)))
typedef unsigned short bf16_t;
typedef short bf16x8 __attribute__((ext_vector_type(8)));
typedef short s16x4 __attribute__((ext_vector_type(4)));
typedef float f32x4 __attribute__((ext_vector_type(4)));
typedef float f32x16 __attribute__((ext_vector_type(16)));
typedef unsigned u32x4 __attribute__((ext_vector_type(4)));
typedef unsigned u32x2 __attribute__((ext_vector_type(2)));

constexpr int DM = 1024, NBATCH = 8, SEQ = 8192, CTXL = 256, NHEAD = 8, HD = 128;
constexpr int INW = 8704, C_Q = 0, C_K = 1024, C_V = 1280, C_HY = 1536, C_POOL = 4608, C_GATE = 5632;
constexpr int DFF = 2816;
constexpr int NLAT = NBATCH * SEQ, NCTX = NBATCH * CTXL, NTOK = NLAT + NCTX;
constexpr int CH_ROWS = 16384;
constexpr int KVLEN = SEQ + CTXL;
constexpr float DN_ALPHA = 1.4142135623730951f;
constexpr float EPSF = 1e-6f;
constexpr int NTHR = 512;
constexpr int FFTN = 16384;
constexpr int LDS_BYTES = 132 * 1024;

constexpr size_t al256(size_t x) { return (x + 255) / 256 * 256; }
constexpr size_t SZ_WIN = (size_t)INW * DM * 2, SZ_WBR = (size_t)3 * DM * DM * 2, SZ_WOUT = (size_t)DM * DM * 2, SZ_W13 = (size_t)2 * DFF * DM * 2, SZ_W2 = (size_t)DM * DFF * 2;
constexpr size_t OFF_WIN = 0;
constexpr size_t OFF_WBR = OFF_WIN + 2 * SZ_WIN;
constexpr size_t OFF_WOUT = OFF_WBR + 2 * SZ_WBR;
constexpr size_t OFF_W13 = OFF_WOUT + 2 * SZ_WOUT;
constexpr size_t OFF_W2 = OFF_W13 + 2 * SZ_W13;
constexpr size_t OFF_MODP = OFF_W2 + 2 * SZ_W2;
constexpr size_t OFF_MOD = OFF_MODP + (size_t)2 * 16 * 9 * 6144 * 4;
constexpr size_t OFF_ROPE = OFF_MOD + (size_t)2 * 9 * 6144 * 4;
constexpr size_t SZ_KF = (size_t)1024 * FFTN * 8;
constexpr size_t OFF_KF = OFF_ROPE + (size_t)128 * 32 * 8;
constexpr size_t OFF_KC = OFF_KF + 2 * SZ_KF;
constexpr size_t OFF_H = OFF_KC + (size_t)1024 * 512 * 4;
constexpr size_t OFF_XLC = OFF_H + (size_t)NTOK * DM * 2;
constexpr size_t OFF_P = OFF_XLC + (size_t)NCTX * DM * 4;
constexpr size_t OFF_ZT = OFF_P + (size_t)CH_ROWS * INW * 2;
constexpr size_t OFF_KALL = OFF_ZT + (size_t)2 * 1024 * SEQ * 2;
constexpr size_t OFF_VALL = OFF_KALL + (size_t)NBATCH * KVLEN * 256 * 2;
constexpr size_t OFF_R2 = OFF_VALL + (size_t)NBATCH * KVLEN * 256 * 2;
constexpr size_t OFF_BAR = OFF_R2 + (size_t)2 * CH_ROWS * DM * 2;
constexpr size_t WS_END = OFF_BAR + 16384;

struct Params { const float* in[29]; float* out; unsigned char* ws; };
enum { I_X = 0, I_C, I_CTX, I_CCTX, I_WADA, I_BADA, I_WIN, I_QG, I_KG, I_HCW, I_HCB, I_HW1, I_HB1, I_HFREQ, I_HW2, I_HB2, I_HW3, I_HYD, I_POOLW, I_POOLS, I_WBR, I_WOUT,
       I_LN1G, I_LN1B, I_LN2G, I_LN2B, I_FW1, I_FW3, I_FW2 };

DEVI int opq_s(int x) { asm volatile("" : "+s"(x)); return x; }
DEVI int opq_v(int x) { asm volatile("" : "+v"(x)); return x; }
DEVI float bf2f(unsigned short b) { return __uint_as_float(((unsigned)b) << 16); }
DEVI unsigned cvt_pk_bf16(float lo, float hi) { unsigned r; asm volatile("v_cvt_pk_bf16_f32 %0, %1, %2" : "=v"(r) : "v"(lo), "v"(hi)); return r; }
DEVI u32x4 pack8(const float* v) { u32x4 w; w.x = cvt_pk_bf16(v[0], v[1]); w.y = cvt_pk_bf16(v[2], v[3]); w.z = cvt_pk_bf16(v[4], v[5]); w.w = cvt_pk_bf16(v[6], v[7]); return w; }
DEVI void unpack8(u32x4 w, float* o) {
    o[0] = __uint_as_float(w.x << 16); o[1] = __uint_as_float(w.x & 0xffff0000u); o[2] = __uint_as_float(w.y << 16); o[3] = __uint_as_float(w.y & 0xffff0000u);
    o[4] = __uint_as_float(w.z << 16); o[5] = __uint_as_float(w.z & 0xffff0000u); o[6] = __uint_as_float(w.w << 16); o[7] = __uint_as_float(w.w & 0xffff0000u); }
DEVI void ld8bf(const bf16_t* p, float* o) { unpack8(*(const u32x4*)p, o); }
DEVI float sigmoidf_(float x) { return __builtin_amdgcn_rcpf(1.f + __expf(-x)); }
DEVI float wave_sum(float v) { for (int m = 32; m >= 1; m >>= 1) v += __shfl_xor(v, m); return v; }

struct Chunk { int isctx, nrows, L, lgL, b0, row0g, koff; float* xl; };
DEVI Chunk mk_chunk(int ci, const Params& p) {
    Chunk c;
    if (ci < 0) { c.isctx = 1; c.nrows = NCTX; c.L = CTXL; c.lgL = 8; c.b0 = 0; c.row0g = NLAT; c.koff = 0; c.xl = (float*)(p.ws + OFF_XLC); }
    else { c.isctx = 0; c.nrows = CH_ROWS; c.L = SEQ; c.lgL = 13; c.b0 = 2 * ci; c.row0g = ci * CH_ROWS; c.koff = CTXL; c.xl = p.out + (size_t)ci * CH_ROWS * DM; }
    return c;
}

namespace pg8 {
constexpr int BM = 256, BK = 64, HALF = 128, HTB = HALF * BK * 2, STAGE_BYTES = 8 * HTB, NXCD = 8, WGM = 8;
DEVI int lds_byte(int r, int c) { const int st = (r >> 4) * 2 + (c >> 5), rr = r & 15, cc = c & 31, ob = rr * 64 + cc * 2; return st * 1024 + (ob ^ (((ob >> 9) & 1) << 5)); }
DEVI void stage_rc(int b, int& R, int& C) { const int st = b / 1024, sb = b % 1024, swz = sb ^ (((sb >> 9) & 1) << 5); R = (st >> 1) * 16 + swz / 64; C = (st & 1) * 32 + (swz % 64) / 2; }
DEVI int perm32(int rho) { const int n = rho >> 4, i = rho & 15; return 8 * (i >> 2) + 4 * n + (i & 3); }
struct Unit { int pm, pn, seg; };
struct Gemm { const bf16_t* A; const bf16_t* Bt; int M, N, K, lda; unsigned a0, a1, a2; size_t bseg; };
struct StaticOrder {
    int nM, nN, nwg, G, c, nseg, revn;
    DEVI void init(int M, int N, int G_, int c_, int nseg_ = 1, int revn_ = 0) { nM = M / BM; nN = N / BM; nwg = nM * nN; G = G_; c = c_; nseg = nseg_; revn = revn_; }
    DEVI bool next(int i, Unit& u) const {
        const int ib = i / nseg; u.seg = i - ib * nseg;
        const long L = (long)ib * G + c; if (L >= nwg) return false;
        int wgid = (int)L; { const int q = nwg / NXCD, r = nwg % NXCD, xcd = wgid % NXCD, off = wgid / NXCD; wgid = (xcd < r ? xcd * (q + 1) : r * (q + 1) + (xcd - r) * q) + off; }
        const int nig = WGM * nN, gid = wgid / nig, fm = gid * WGM, gsz = (nM - fm) < WGM ? (nM - fm) : WGM;
        u.pm = fm + ((wgid % nig) % gsz); u.pn = (wgid % nig) / gsz; if (revn) u.pn = nN - 1 - u.pn; return true;
    }
};
template <class Epi>
DEVI void gemm_phase(LAS unsigned char* lds, const Gemm g, const StaticOrder& S, const Epi& E) {
    const int tid = opq_v(threadIdx.x), wid = __builtin_amdgcn_readfirstlane(tid >> 6), lane = tid & 63, wr = wid >> 2, wc = wid & 3, fr = lane & 15, fq = lane >> 4;
    const int K = g.K, nt = K / BK;
    unsigned voffA[2], voffB[2];
#pragma unroll
    for (int i = 0; i < 2; ++i) { int R, C; stage_rc(tid * 16 + i * 8192, R, C); const int Rb = (R & ~31) + perm32(R & 31);
        voffA[i] = (unsigned)(R * g.lda + C) * 2u; voffB[i] = (unsigned)(Rb * K + C) * 2u; }
    const size_t kstep = (size_t)(BK * 2);
    const size_t hstepA = (size_t)HALF * g.lda * 2, hstepB = (size_t)HALF * K * 2;
    const size_t tstepA = 2 * hstepA, tstepB = 2 * hstepB;
    const unsigned ldsw = (unsigned)wid * 1024u;
    const int aoff = lds_byte(wr * 64 + fr, fq * 8), boff = lds_byte(wc * 32 + fr, fq * 8);
#define PG8_SA(b, h) (((b) * 2 + (h)) * HTB)
#define PG8_SB(b, h) ((4 + (b) * 2 + (h)) * HTB)
#define PG8_STAGE(bufoff, gbase, voff) do { _Pragma("unroll") for (int _i = 0; _i < 2; ++_i) \
        __builtin_amdgcn_global_load_lds((const unsigned*)((const char*)(gbase) + (voff)[_i]), (LAS unsigned*)(lds + (bufoff) + ldsw + _i * 8192), 16, 0, 0); } while (0)
#define PG8_LDA(dst, b, h) do { _Pragma("unroll") for (int m = 0; m < 4; ++m) _Pragma("unroll") for (int k = 0; k < 2; ++k) dst[m][k] = *(const LAS bf16x8*)(lds + PG8_SA(b, h) + aoff + m * 2048 + k * 1024); } while (0)
#define PG8_LDB(dst, b, h) do { _Pragma("unroll") for (int n = 0; n < 2; ++n) _Pragma("unroll") for (int k = 0; k < 2; ++k) dst[n][k] = *(const LAS bf16x8*)(lds + PG8_SB(b, h) + boff + n * 2048 + k * 1024); } while (0)
#define PG8_MMA(ai, bj, At, Bt) do { __builtin_amdgcn_s_setprio(1); _Pragma("unroll") for (int m = 0; m < 4; ++m) _Pragma("unroll") for (int n = 0; n < 2; ++n) _Pragma("unroll") for (int k = 0; k < 2; ++k) \
        acc[ai][bj][m][n] = __builtin_amdgcn_mfma_f32_16x16x32_bf16(Bt[n][k], At[m][k], acc[ai][bj][m][n], 0, 0, 0); __builtin_amdgcn_s_setprio(0); } while (0)
#define PG8_WAIT_V(n) asm volatile("s_waitcnt vmcnt(" #n ")" ::: "memory")
#define PG8_WAIT_L(n) asm volatile("s_waitcnt lgkmcnt(" #n ")" ::: "memory")
#define PG8_BAR __builtin_amdgcn_s_barrier()
#define PG8_SCHED __builtin_amdgcn_sched_barrier(0)
    Unit cur, nxt; int ui = 0;
    if (!S.next(0, cur)) return;
    f32x4 acc[2][2][4][2];
#pragma unroll
    for (int a = 0; a < 2; ++a)
#pragma unroll
        for (int b = 0; b < 2; ++b)
#pragma unroll
            for (int m = 0; m < 4; ++m)
#pragma unroll
                for (int n = 0; n < 2; ++n) acc[a][b][m][n] = (f32x4){0.f, 0.f, 0.f, 0.f};
    bf16x8 At[4][2], B0[2][2], B1[2][2];
#define PG8_ABASE(u) ((const char*)g.A + ((u).seg == 0 ? g.a0 : ((u).seg == 1 ? g.a1 : g.a2)) + (size_t)(u).pm * tstepA)
#define PG8_BBASE(u) ((const char*)g.Bt + (size_t)(u).seg * g.bseg + (size_t)(u).pn * tstepB)
    const char* cA = PG8_ABASE(cur); const char* cB = PG8_BBASE(cur);
    PG8_STAGE(PG8_SB(0, 0), cB, voffB); PG8_STAGE(PG8_SA(0, 0), cA, voffA); PG8_STAGE(PG8_SB(0, 1), cB + hstepB, voffB); PG8_STAGE(PG8_SA(0, 1), cA + hstepA, voffA);
    if (wr == 1) PG8_BAR;
    PG8_WAIT_V(4); PG8_BAR;
    PG8_STAGE(PG8_SB(1, 0), cB + kstep, voffB); PG8_STAGE(PG8_SA(1, 0), cA + kstep, voffA); PG8_STAGE(PG8_SB(1, 1), cB + hstepB + kstep, voffB);
    PG8_WAIT_V(6); PG8_BAR;
    for (;;) {
        const bool has_next = S.next(ui + 1, nxt);
        const char* nA = has_next ? PG8_ABASE(nxt) : cA; const char* nB = has_next ? PG8_BBASE(nxt) : cB;
        for (int t = 0; t < nt; t += 2) {
            const bool last = (t == nt - 2);
            const char* a1 = cA + (size_t)(t + 1) * kstep;
            const char* a2 = last ? nA : cA + (size_t)(t + 2) * kstep; const char* b2 = last ? nB : cB + (size_t)(t + 2) * kstep;
            const char* a3 = a2 + kstep; const char* b3 = b2 + kstep;
            PG8_LDB(B0, 0, 0); PG8_SCHED; PG8_LDA(At, 0, 0); PG8_STAGE(PG8_SA(1, 1), a1 + hstepA, voffA);
            PG8_WAIT_L(8); PG8_BAR; PG8_WAIT_L(0); PG8_MMA(0, 0, At, B0); PG8_BAR; PG8_SCHED;
            PG8_LDB(B1, 0, 1); PG8_STAGE(PG8_SB(0, 0), b2, voffB);
            PG8_BAR; PG8_WAIT_L(0); PG8_MMA(0, 1, At, B1); PG8_BAR;
            PG8_LDA(At, 0, 1); PG8_STAGE(PG8_SA(0, 0), a2, voffA);
            PG8_BAR; PG8_WAIT_L(0); PG8_MMA(1, 0, At, B0); PG8_BAR; PG8_SCHED;
            PG8_STAGE(PG8_SB(0, 1), b2 + hstepB, voffB);
            PG8_WAIT_V(6); PG8_BAR; PG8_MMA(1, 1, At, B1); PG8_BAR;
            PG8_LDB(B0, 1, 0); PG8_SCHED; PG8_LDA(At, 1, 0); PG8_STAGE(PG8_SA(0, 1), a2 + hstepA, voffA);
            PG8_WAIT_L(8); PG8_BAR; PG8_WAIT_L(0); PG8_MMA(0, 0, At, B0); PG8_BAR; PG8_SCHED;
            PG8_LDB(B1, 1, 1); PG8_STAGE(PG8_SB(1, 0), b3, voffB);
            PG8_BAR; PG8_WAIT_L(0); PG8_MMA(0, 1, At, B1); PG8_BAR;
            PG8_LDA(At, 1, 1); PG8_STAGE(PG8_SA(1, 0), a3, voffA);
            PG8_BAR; PG8_WAIT_L(0); PG8_MMA(1, 0, At, B0); PG8_BAR; PG8_SCHED;
            PG8_STAGE(PG8_SB(1, 1), b3 + hstepB, voffB);
            PG8_WAIT_V(6); PG8_BAR; PG8_MMA(1, 1, At, B1); PG8_BAR;
        }
        E(acc, cur, wr, wc, fr, fq);
        if (!has_next) break;
#pragma unroll
        for (int a = 0; a < 2; ++a)
#pragma unroll
            for (int b = 0; b < 2; ++b)
#pragma unroll
                for (int m = 0; m < 4; ++m)
#pragma unroll
                    for (int n = 0; n < 2; ++n) acc[a][b][m][n] = (f32x4){0.f, 0.f, 0.f, 0.f};
        cur = nxt; cA = nA; cB = nB; ++ui;
    }
    PG8_WAIT_V(0);
    if (wr == 0) PG8_BAR;
    PG8_BAR;
#undef PG8_ABASE
#undef PG8_BBASE
#undef PG8_SA
#undef PG8_SB
#undef PG8_STAGE
#undef PG8_LDA
#undef PG8_LDB
#undef PG8_MMA
#undef PG8_WAIT_V
#undef PG8_WAIT_L
#undef PG8_BAR
#undef PG8_SCHED
}
}

typedef const f32x4 (&AccRef)[2][2][4][2];
#define EPI_LOOP_BEGIN \
    const int row0 = u.pm * 256 + wr * 64 + fr; const int colu = u.pn * 256 + wc * 32 + 8 * fq; \
    _Pragma("unroll") for (int ai = 0; ai < 2; ++ai) _Pragma("unroll") for (int m = 0; m < 4; ++m) { const int r = row0 + ai * 128 + m * 16; \
    _Pragma("unroll") for (int bj = 0; bj < 2; ++bj) { const int c = colu + bj * 128; float v[8]; \
        v[0] = acc[ai][bj][m][0][0]; v[1] = acc[ai][bj][m][0][1]; v[2] = acc[ai][bj][m][0][2]; v[3] = acc[ai][bj][m][0][3]; \
        v[4] = acc[ai][bj][m][1][0]; v[5] = acc[ai][bj][m][1][1]; v[6] = acc[ai][bj][m][1][2]; v[7] = acc[ai][bj][m][1][3];
#define EPI_LOOP_END } }

struct EpiA {
    bf16_t* P; bf16_t* vall; int lgL, Lm1, b0, koff, col_off;
    DEVI void operator()(AccRef acc, const pg8::Unit& u, int wr, int wc, int fr, int fq) const {
        const int colt = u.pn * 256 + col_off;
        EPI_LOOP_BEGIN
            const int cc = c + col_off;
            if (colt >= C_V && colt < C_HY) { const size_t kvrow = (size_t)(b0 + (r >> lgL)) * KVLEN + koff + (r & Lm1); *(u32x4*)(vall + kvrow * 256 + (cc - C_V)) = pack8(v); }
            else { if (colt >= C_GATE) {
#pragma unroll
                    for (int i = 0; i < 8; ++i) v[i] = sigmoidf_(v[i]); }
                *(u32x4*)(P + (size_t)r * INW + cc) = pack8(v); }
        EPI_LOOP_END
    }
};
struct EpiMerge {
    const bf16_t* P; bf16_t* mg;
    DEVI void operator()(AccRef acc, const pg8::Unit& u, int wr, int wc, int fr, int fq) const {
        const bf16_t* gate = P + C_GATE + u.seg * DM; const bool first = (u.seg == 0);
        EPI_LOOP_BEGIN
            float gv[8]; ld8bf(gate + (size_t)r * INW + c, gv);
            bf16_t* mp = mg + (size_t)r * DM + c;
            float t[8];
            if (first) {
#pragma unroll
                for (int i = 0; i < 8; ++i) t[i] = gv[i] * v[i]; }
            else { float a[8]; ld8bf(mp, a);
#pragma unroll
                for (int i = 0; i < 8; ++i) t[i] = a[i] + gv[i] * v[i]; }
            *(u32x4*)mp = pack8(t);
        EPI_LOOP_END
    }
};
struct EpiRes {
    const float* xl; const float* gmod; float* Y; int lgL, b0, isctx;
    DEVI void operator()(AccRef acc, const pg8::Unit& u, int wr, int wc, int fr, int fq) const {
        EPI_LOOP_BEGIN
            const int mi = isctx ? 8 : b0 + (r >> lgL);
            const float* gp = gmod + (size_t)mi * 6144 + c; const float* xp = xl + (size_t)r * DM + c; float* yp = Y + (size_t)r * DM + c;
            const f32x4 g0 = *(const f32x4*)gp, g1 = *(const f32x4*)(gp + 4), x0 = *(const f32x4*)xp, x1 = *(const f32x4*)(xp + 4);
            *(f32x4*)yp = (f32x4){DN_ALPHA * x0[0] + g0[0] * v[0], DN_ALPHA * x0[1] + g0[1] * v[1], DN_ALPHA * x0[2] + g0[2] * v[2], DN_ALPHA * x0[3] + g0[3] * v[3]};
            *(f32x4*)(yp + 4) = (f32x4){DN_ALPHA * x1[0] + g1[0] * v[4], DN_ALPHA * x1[1] + g1[1] * v[5], DN_ALPHA * x1[2] + g1[2] * v[6], DN_ALPHA * x1[3] + g1[3] * v[7]};
        EPI_LOOP_END
    }
};
struct EpiF1 {
    bf16_t* G;
    DEVI void operator()(AccRef acc, const pg8::Unit& u, int wr, int wc, int fr, int fq) const {
        EPI_LOOP_BEGIN
            float o[4];
#pragma unroll
            for (int i = 0; i < 4; ++i) o[i] = v[i] * sigmoidf_(v[i]) * v[4 + i];
            u32x2 w; w.x = cvt_pk_bf16(o[0], o[1]); w.y = cvt_pk_bf16(o[2], o[3]);
            *(u32x2*)(G + (size_t)r * DFF + (c >> 1)) = w;
        EPI_LOOP_END
    }
};

namespace att {
constexpr int D = 128, NW = 8, QBLK = 32, KVBLK = 64;
constexpr float SCALE = 0.088388347648318440f;
constexpr float THR = 8.f;
constexpr size_t SHM_V = KVBLK * D * 2, SHM_K = KVBLK * D * 2, SHM_ATTN = 2 * SHM_V + 2 * SHM_K + NW * 64 * 4;
#define KSWZ(row, colB) ((row) * 256 + ((colB) ^ (((row) & 7) << 4)))
#define SBAR() __builtin_amdgcn_sched_barrier(0)
DEVI int crow(int r, int hi) { return (r & 3) + 8 * (r >> 2) + 4 * hi; }
DEVI void partialSM(f32x16& p0, f32x16& p1, float mnC) {
  if (mnC != 0.f) { for (int r = 0; r < 16; ++r) p0[r] += mnC; for (int r = 0; r < 16; ++r) p1[r] += mnC; }
  for (int r = 0; r < 16; ++r) p0[r] = __builtin_amdgcn_exp2f(p0[r]);
}
DEVI void finishSM(f32x16& p0, f32x16& p1, float& l_reg, bf16x8& pa0, bf16x8& pa1, bf16x8& pa2, bf16x8& pa3) {
  for (int r = 0; r < 16; ++r) p1[r] = __builtin_amdgcn_exp2f(p1[r]);
  float ps = 0; for (int r = 0; r < 16; ++r) ps += p0[r]; for (int r = 0; r < 16; ++r) ps += p1[r];
  { auto rr = __builtin_amdgcn_permlane32_swap(__float_as_uint(ps), __float_as_uint(ps), false, false);
    ps = __uint_as_float(rr[0]) + __uint_as_float(rr[1]); }
  l_reg += ps;
#define PK4(P, BASE, OUT) do { unsigned a0 = cvt_pk_bf16(P[BASE + 0], P[BASE + 1]), a1 = cvt_pk_bf16(P[BASE + 2], P[BASE + 3]);   \
    unsigned b0 = cvt_pk_bf16(P[BASE + 4], P[BASE + 5]), b1 = cvt_pk_bf16(P[BASE + 6], P[BASE + 7]);                              \
    auto r0 = __builtin_amdgcn_permlane32_swap(a0, b0, false, false); auto r1 = __builtin_amdgcn_permlane32_swap(a1, b1, false, false); \
    u32x4 w = {r0[0], r1[0], r0[1], r1[1]}; OUT = *reinterpret_cast<bf16x8*>(&w); } while (0)
  PK4(p0, 0, pa0); PK4(p0, 8, pa1); PK4(p1, 0, pa2); PK4(p1, 8, pa3);
#undef PK4
}
DEVI void qkt(f32x16& p0, f32x16& p1, const bf16_t* Ks, const bf16x8* qr, int r32, int hi) {
  p0 = f32x16{}; p1 = f32x16{};
  for (int d0 = 0; d0 < 8; ++d0) { int cb = (d0 * 16 + hi * 8) * 2;
    bf16x8 b0 = *reinterpret_cast<const bf16x8*>((const char*)Ks + KSWZ(r32, cb));
    bf16x8 b1 = *reinterpret_cast<const bf16x8*>((const char*)Ks + KSWZ(32 + r32, cb));
    p0 = __builtin_amdgcn_mfma_f32_32x32x16_bf16(b0, qr[d0], p0, 0, 0, 0);
    p1 = __builtin_amdgcn_mfma_f32_32x32x16_bf16(b1, qr[d0], p1, 0, 0, 0); }
}
DEVI int v_st(int k, int c) { const int kk = (k & ~0xC) | ((k & 4) << 1) | ((k & 8) >> 1); return ((kk >> 3) * 4 + (c >> 5)) * 512 + ((kk & 7) * 32 + (c & 31)) * 2; }
DEVI int v_rd_base(int lane) { return ((lane & 3) << 3) | (((lane >> 2) & 3) << 6) | (((lane >> 4) & 1) << 5) | (((lane >> 5) & 1) << 8); }
constexpr int v_rd_off(int d0, int ks, int half) { return d0 * 512 + ks * 4096 + half * 2048; }
template <int OFF> DEVI s16x4 tr_read(int vb) {
  s16x4 r; asm volatile("ds_read_b64_tr_b16 %0, %1 offset:%2" : "=&v"(r) : "v"(vb), "i"(OFF) : "memory"); return r;
}
template <int D0> DEVI void pv_one(f32x16& od, int vb, bf16x8 pa0, bf16x8 pa1, bf16x8 pa2, bf16x8 pa3) {
  const s16x4 l0 = tr_read<v_rd_off(D0, 0, 0)>(vb), h0 = tr_read<v_rd_off(D0, 0, 1)>(vb), l1 = tr_read<v_rd_off(D0, 1, 0)>(vb), h1 = tr_read<v_rd_off(D0, 1, 1)>(vb);
  const s16x4 l2 = tr_read<v_rd_off(D0, 2, 0)>(vb), h2 = tr_read<v_rd_off(D0, 2, 1)>(vb), l3 = tr_read<v_rd_off(D0, 3, 0)>(vb), h3 = tr_read<v_rd_off(D0, 3, 1)>(vb);
  asm volatile("s_waitcnt lgkmcnt(0)" ::: "memory"); SBAR();
#define PK(L, H) (bf16x8){L[0], L[1], L[2], L[3], H[0], H[1], H[2], H[3]}
  od = __builtin_amdgcn_mfma_f32_32x32x16_bf16(pa0, PK(l0, h0), od, 0, 0, 0);
  od = __builtin_amdgcn_mfma_f32_32x32x16_bf16(pa1, PK(l1, h1), od, 0, 0, 0);
  od = __builtin_amdgcn_mfma_f32_32x32x16_bf16(pa2, PK(l2, h2), od, 0, 0, 0);
  od = __builtin_amdgcn_mfma_f32_32x32x16_bf16(pa3, PK(l3, h3), od, 0, 0, 0);
#undef PK
}
DEVI void pv_d0(f32x16* o, int vb, bf16x8 pa0, bf16x8 pa1, bf16x8 pa2, bf16x8 pa3) {
  pv_one<0>(o[0], vb, pa0, pa1, pa2, pa3); pv_one<1>(o[1], vb, pa0, pa1, pa2, pa3); pv_one<2>(o[2], vb, pa0, pa1, pa2, pa3); pv_one<3>(o[3], vb, pa0, pa1, pa2, pa3);
}
DEVI void attn_dense_body(const bf16_t* Qb, const bf16_t* Kh, const bf16_t* Vh, bf16_t* Ob, int seq, int ldq, int ldk, int ldo, float mshift, char* lds) {
  const int tid = opq_v(threadIdx.x), wid = tid >> 6, lane = tid & 63, r32 = lane & 31, hi = lane >> 5;
  bf16_t* V_lds = (bf16_t*)lds; bf16_t* K_lds = (bf16_t*)(lds + 2 * SHM_V);
  float* ws = (float*)(lds + 2 * SHM_V + 2 * SHM_K) + wid * 64; float* li_l = ws;
  const float mnC = (mshift * 1.4426950408889634f > 60.f) ? -mshift * 1.4426950408889634f : 0.f; float l_reg = 0; f32x16 o[4] = {}; bf16x8 qr[8];
  const bf16_t* Qw = Qb + (long)(wid * QBLK + r32) * ldq + hi * 8;
#pragma unroll
  for (int d0 = 0; d0 < 8; ++d0) qr[d0] = *reinterpret_cast<const bf16x8*>(Qw + d0 * 16);
  const int sr = tid >> 4, sc = (tid & 15) * 8, vst0 = v_st(sr, sc), vst1 = v_st(32 + sr, sc);
  const int vb0 = (int)(uintptr_t)V_lds + v_rd_base(lane);
  struct { bf16x8 vs0, vs1, ks0, ks1; } sr_[2];
  const unsigned goff0 = (unsigned)(sr * ldk + sc) * 2u, goff1 = (unsigned)((32 + sr) * ldk + sc) * 2u;
#define SLOAD(i, k0) do { const char* vbp_ = (const char*)Vh + (size_t)(k0) * ldk * 2; const char* kbp_ = (const char*)Kh + (size_t)(k0) * ldk * 2; \
    sr_[i].vs0 = *reinterpret_cast<const bf16x8*>(vbp_ + goff0); sr_[i].vs1 = *reinterpret_cast<const bf16x8*>(vbp_ + goff1); \
    sr_[i].ks0 = *reinterpret_cast<const bf16x8*>(kbp_ + goff0); sr_[i].ks1 = *reinterpret_cast<const bf16x8*>(kbp_ + goff1); } while (0)
#define SWRITE(b, i) do { *(bf16x8*)((char*)V_lds + (b) * SHM_V + vst0) = sr_[i].vs0;          \
    *(bf16x8*)((char*)V_lds + (b) * SHM_V + vst1) = sr_[i].vs1; int kc = sc * 2;               \
    *(bf16x8*)((char*)K_lds + (b) * SHM_K + KSWZ(sr, kc)) = sr_[i].ks0;                       \
    *(bf16x8*)((char*)K_lds + (b) * SHM_K + KSWZ(32 + sr, kc)) = sr_[i].ks1; } while (0)
#define SWAIT() do { asm volatile("s_waitcnt vmcnt(4)" ::: "memory"); } while (0)
  f32x16 pA0, pA1, pB0, pB1; bf16x8 pa0, pa1, pa2, pa3; const int NT = seq / KVBLK;
  constexpr int SE = 0, SO = 1;
  SLOAD(SE, 0); asm volatile("s_waitcnt vmcnt(0)" ::: "memory"); SWRITE(0, SE); __syncthreads();
  qkt(pA0, pA1, K_lds, qr, r32, hi); partialSM(pA0, pA1, mnC);
  SLOAD(SO, KVBLK); if (2 < NT) SLOAD(SE, 2 * KVBLK);
  SWAIT(); SWRITE(1, SO); __syncthreads();
  for (int j = 1; j + 1 < NT; j += 2) {
    SBAR(); qkt(pB0, pB1, (bf16_t*)((char*)K_lds + SHM_K), qr, r32, hi);
    finishSM(pA0, pA1, l_reg, pa0, pa1, pa2, pa3); SBAR();
    SLOAD(SO, (j + 2) * KVBLK); SBAR();
    pv_d0(o, vb0, pa0, pa1, pa2, pa3); partialSM(pB0, pB1, mnC);
    __syncthreads(); SWAIT(); SWRITE(0, SE);
    __syncthreads();
    SBAR(); qkt(pA0, pA1, K_lds, qr, r32, hi);
    finishSM(pB0, pB1, l_reg, pa0, pa1, pa2, pa3); SBAR();
    if (j + 3 < NT) SLOAD(SE, (j + 3) * KVBLK); SBAR();
    pv_d0(o, vb0 + (int)SHM_V, pa0, pa1, pa2, pa3); partialSM(pA0, pA1, mnC);
    __syncthreads(); SWAIT(); SWRITE(1, SO);
    __syncthreads();
  }
  SBAR(); qkt(pB0, pB1, (bf16_t*)((char*)K_lds + SHM_K), qr, r32, hi);
  finishSM(pA0, pA1, l_reg, pa0, pa1, pa2, pa3); SBAR();
  pv_d0(o, vb0, pa0, pa1, pa2, pa3); partialSM(pB0, pB1, mnC);
  __syncthreads();
  finishSM(pB0, pB1, l_reg, pa0, pa1, pa2, pa3); SBAR();
  pv_d0(o, vb0 + (int)SHM_V, pa0, pa1, pa2, pa3);
  if (hi == 0) li_l[r32] = l_reg; asm volatile("s_waitcnt lgkmcnt(0)" ::: "memory");
  float rli[16];
#pragma unroll
  for (int r = 0; r < 16; ++r) rli[r] = __builtin_amdgcn_rcpf(li_l[crow(r, hi)]);
  bf16_t* Ow = Ob + (long)(wid * QBLK) * ldo;
#pragma unroll
  for (int r = 0; r < 16; ++r) { int orow = crow(r, hi);
#pragma unroll
    for (int d0 = 0; d0 < 4; ++d0) Ow[(long)orow * ldo + d0 * 32 + r32] = (bf16_t)(cvt_pk_bf16(o[d0][r] * rli[r], 0.f) & 0xffffu); }
  __syncthreads();
#undef SLOAD
#undef SWRITE
#undef SWAIT
}
}

DEVI float2 cmul(float2 a, float2 b) { return make_float2(a.x * b.x - a.y * b.y, a.x * b.y + a.y * b.x); }
DEVI float2 cmulc(float2 a, float2 b) { return make_float2(a.x * b.x + a.y * b.y, a.y * b.x - a.x * b.y); }
DEVI float2 cadd(float2 a, float2 b) { return make_float2(a.x + b.x, a.y + b.y); }
DEVI float2 csub(float2 a, float2 b) { return make_float2(a.x - b.x, a.y - b.y); }
DEVI void fft_tables(float2* tab) {
    const int tid = opq_v(threadIdx.x);
    if (tid < 128) { const int k = tid < 64 ? tid : (tid - 64) * 64; float s, c; sincospif(-(float)k / 8192.f, &s, &c); tab[tid] = make_float2(c, s); }
}
DEVI int sw(int i) { return i ^ ((i >> 5) & 1) ^ (((i >> 6) & 1) * 6) ^ (((i >> 7) & 3) << 3); }
DEVI float2 twid(const float2* tab, int k) { return cmul(tab[k & 63], tab[64 + (k >> 6)]); }
template <int LQ> DEVI void fft_fwd_pass(float2* X, const float2* tab) {
    constexpr int q = 1 << LQ; const int tid = opq_v(threadIdx.x);
#pragma unroll 2
    for (int i = 0; i < 8; ++i) {
        const int g = tid + NTHR * i; const int j = g & (q - 1); const int base = ((g >> LQ) << (LQ + 2)) + j;
        const int a0 = sw(base), a1 = sw(base + q), a2 = sw(base + 2 * q), a3 = sw(base + 3 * q);
        const float2 e0 = X[a0], e1 = X[a1], e2 = X[a2], e3 = X[a3];
        const float2 w1 = twid(tab, j << (12 - LQ)), w2 = cmul(w1, w1);
        const float2 f0 = cadd(e0, e2), f2 = cmul(csub(e0, e2), w1), f1 = cadd(e1, e3), d13 = csub(e1, e3);
        const float2 f3 = cmul(make_float2(d13.y, -d13.x), w1);
        X[a0] = cadd(f0, f1); X[a1] = cmul(csub(f0, f1), w2); X[a2] = cadd(f2, f3); X[a3] = cmul(csub(f2, f3), w2);
    }
    __syncthreads();
}
template <int LQ> DEVI void fft_inv_pass(float2* X, const float2* tab) {
    constexpr int q = 1 << LQ; const int tid = opq_v(threadIdx.x);
#pragma unroll 2
    for (int i = 0; i < 8; ++i) {
        const int g = tid + NTHR * i; const int j = g & (q - 1); const int base = ((g >> LQ) << (LQ + 2)) + j;
        const int a0 = sw(base), a1 = sw(base + q), a2 = sw(base + 2 * q), a3 = sw(base + 3 * q);
        const float2 g0 = X[a0], g1 = X[a1], g2 = X[a2], g3 = X[a3];
        const float2 w1 = twid(tab, j << (12 - LQ)), w2 = cmul(w1, w1);
        const float2 t = cmulc(g1, w2), f0 = cadd(g0, t), f1 = csub(g0, t), t2 = cmulc(g3, w2), f2 = cadd(g2, t2), f3 = csub(g2, t2);
        const float2 uu = cmulc(f2, w1), vv = cmulc(f3, w1), u2 = make_float2(-vv.y, vv.x);
        X[a0] = cadd(f0, uu); X[a2] = csub(f0, uu); X[a1] = cadd(f1, u2); X[a3] = csub(f1, u2);
    }
    __syncthreads();
}
DEVI void r4f(float2& e0, float2& e1, float2& e2, float2& e3, float2 w1, float2 w2) {
    const float2 f0 = cadd(e0, e2), f2 = cmul(csub(e0, e2), w1), f1 = cadd(e1, e3), d13 = csub(e1, e3);
    const float2 f3 = cmul(make_float2(d13.y, -d13.x), w1);
    e0 = cadd(f0, f1); e1 = cmul(csub(f0, f1), w2); e2 = cadd(f2, f3); e3 = cmul(csub(f2, f3), w2);
}
DEVI void r4i(float2& g0, float2& g1, float2& g2, float2& g3, float2 w1, float2 w2) {
    const float2 t = cmulc(g1, w2), f0 = cadd(g0, t), f1 = csub(g0, t), t2 = cmulc(g3, w2), f2 = cadd(g2, t2), f3 = csub(g2, t2);
    const float2 uu = cmulc(f2, w1), vv = cmulc(f3, w1), u2 = make_float2(-vv.y, vv.x);
    g0 = cadd(f0, uu); g2 = csub(f0, uu); g1 = cadd(f1, u2); g3 = csub(f1, u2);
}
template <int LQ> DEVI int r16_sb(int base) {
    if (LQ == 10) return sw(base);
    if (LQ == 6) return base ^ ((base >> 5) & 1);
    return base ^ ((((base >> 6) & 1) * 6) ^ (((base >> 7) & 3) << 3));
}
template <int LQ> DEVI int r16_addr(int sb, int e) {
    if (LQ == 10) return sb + e * 1024;
    if (LQ == 6) return (sb ^ (((e & 1) * 6) ^ (((e >> 1) & 3) << 3))) + 64 * e;
    return sb ^ ((4 * e) ^ (e >> 3));
}
template <int LQ, bool INV, int HALF = 0> DEVI void fft_r16_pass(float2* X, const float2* tab) {
    constexpr int q = 1 << LQ; const int tid = opq_v(threadIdx.x);
#pragma unroll 1
    for (int i = 0; i < 2; ++i) {
        const int g = tid + NTHR * i; const int j = g & (q - 1); const int base = ((g >> LQ) << (LQ + 4)) + j;
        float2 x[16]; const int sb = r16_sb<LQ>(base);
#pragma unroll
        for (int e = 0; e < 16; ++e) x[e] = (HALF == 1 && e >= 8) ? make_float2(0.f, 0.f) : X[r16_addr<LQ>(sb, e)];
        const float2 wb = twid(tab, j << (10 - LQ));
        float2 w[4]; w[0] = wb; w[1] = cmul(wb, make_float2(0.92387953251128674f, -0.38268343236508977f)); w[2] = cmul(wb, make_float2(0.70710678118654752f, -0.70710678118654752f));
        w[3] = cmul(wb, make_float2(0.38268343236508977f, -0.92387953251128674f));
        const float2 wb2 = cmul(wb, wb), w4 = cmul(wb2, wb2), w8 = cmul(w4, w4);
        if (!INV) {
#pragma unroll
            for (int e = 0; e < 4; ++e) r4f(x[e], x[e + 4], x[e + 8], x[e + 12], w[e], cmul(w[e], w[e]));
#pragma unroll
            for (int m = 0; m < 4; ++m) r4f(x[4 * m], x[4 * m + 1], x[4 * m + 2], x[4 * m + 3], w4, w8);
        } else {
#pragma unroll
            for (int m = 0; m < 4; ++m) r4i(x[4 * m], x[4 * m + 1], x[4 * m + 2], x[4 * m + 3], w4, w8);
#pragma unroll
            for (int e = 0; e < 4; ++e) r4i(x[e], x[e + 4], x[e + 8], x[e + 12], w[e], cmul(w[e], w[e]));
        }
#pragma unroll
        for (int e = 0; e < 16; ++e) if (!(HALF == 2 && e >= 8)) X[r16_addr<LQ>(sb, e)] = x[e];
    }
    __syncthreads();
}
DEVI void fft_mid_mul(float2* X, const unsigned* kfc) {
    const int tid = opq_v(threadIdx.x);
#pragma unroll 1
    for (int ib = 0; ib < 8; ib += 4) {
        u32x4 kq[4];
#pragma unroll
        for (int u = 0; u < 4; ++u) { const int base = (tid + NTHR * (ib + u)) * 4; kq[u] = *(const u32x4*)(kfc + base); }
#pragma unroll
        for (int u = 0; u < 4; ++u) {
            const int base = (tid + NTHR * (ib + u)) * 4;
            const int a0 = sw(base), a1 = sw(base + 1), a2 = sw(base + 2), a3 = sw(base + 3);
            const float2 e0 = X[a0], e1 = X[a1], e2 = X[a2], e3 = X[a3];
            const float2 f0 = cadd(e0, e2), f2 = csub(e0, e2), f1 = cadd(e1, e3), d13 = csub(e1, e3), f3 = make_float2(d13.y, -d13.x);
#define KFC(w) make_float2(__uint_as_float((w) << 16), __uint_as_float((w) & 0xffff0000u))
            const float2 g0 = cmul(cadd(f0, f1), KFC(kq[u][0])), g1 = cmul(csub(f0, f1), KFC(kq[u][1]));
            const float2 g2 = cmul(cadd(f2, f3), KFC(kq[u][2])), g3 = cmul(csub(f2, f3), KFC(kq[u][3]));
#undef KFC
            const float2 h0 = cadd(g0, g1), h1 = csub(g0, g1), h2 = cadd(g2, g3), h3 = csub(g2, g3), u2 = make_float2(-h3.y, h3.x);
            X[a0] = cadd(h0, h2); X[a2] = csub(h0, h2); X[a1] = cadd(h1, u2); X[a3] = csub(h1, u2);
        }
    }
    __syncthreads();
}
DEVI void fft_fwd(float2* X, const float2* tab) { fft_r16_pass<10, false>(X, tab); fft_r16_pass<6, false>(X, tab); fft_r16_pass<2, false>(X, tab); fft_fwd_pass<0>(X, tab); }
DEVI void fft_inv(float2* X, const float2* tab) { fft_inv_pass<0>(X, tab); fft_r16_pass<2, true>(X, tab); fft_r16_pass<6, true>(X, tab); fft_r16_pass<10, true>(X, tab); }

DEVI float block_sum(float v, float* red) {
    v = wave_sum(v); const int tid = opq_v(threadIdx.x);
    __syncthreads();
    if ((tid & 63) == 0) red[tid >> 6] = v;
    __syncthreads();
    float s = 0.f;
#pragma unroll
    for (int i = 0; i < 8; ++i) s += red[i];
    return s;
}

template <int MAP> DEVI void wt_transpose(const float* src, int K, int N, bf16_t* dst, float* lds, int bid, int nb) {
    const int tid = opq_v(threadIdx.x), ntn = N / 256, ntiles = (K / 64) * ntn;
    for (int tile = bid; tile < ntiles; tile += nb) {
        const int k0 = (tile / ntn) * 64, n0 = (tile % ntn) * 256;
        __syncthreads();
        f32x4 v[8];
#pragma unroll
        for (int ps = 0; ps < 8; ++ps) v[ps] = *(const f32x4*)(src + (size_t)(k0 + (tid >> 6) + 8 * ps) * N + n0 + (tid & 63) * 4);
#pragma unroll
        for (int ps = 0; ps < 8; ++ps) { const int kk = (tid >> 6) + 8 * ps, nn = (tid & 63) * 4;
            lds[kk * 257 + nn] = v[ps][0]; lds[kk * 257 + nn + 1] = v[ps][1]; lds[kk * 257 + nn + 2] = v[ps][2]; lds[kk * 257 + nn + 3] = v[ps][3]; }
        __syncthreads();
#pragma unroll
        for (int ps = 0; ps < 4; ++ps) { const int nn = (tid >> 3) + 64 * ps, k8 = (tid & 7) * 8; float o[8];
#pragma unroll
            for (int i = 0; i < 8; ++i) o[i] = lds[(k8 + i) * 257 + nn];
            const int n = n0 + nn; const int nd = MAP == 0 ? n : (8 * (n >> 2) + (n & 3) + (MAP == 2 ? 4 : 0));
            *(u32x4*)(dst + (size_t)nd * K + k0 + k8) = pack8(o); }
    }
}
DEVI void wpc_job(const float* pool_w, const float* pool_s, const float* wb2, bf16_t* dst, float* lds, int bid, int nb) {
    const int tid = opq_v(threadIdx.x);
    float* sa = lds;
    float* sb = lds + 64 * 257;
    for (int tile = bid; tile < 256; tile += nb) {
        const int g = tile >> 6, c0 = ((tile >> 4) & 3) * 64, e0 = (tile & 15) * 64;
        __syncthreads();
        for (int idx = tid; idx < 64 * 256; idx += NTHR) { const int cc = idx >> 8, d = idx & 255; sa[cc * 257 + d] = pool_w[((size_t)g * 256 + c0 + cc) * 256 + d]; }
        for (int idx = tid; idx < 256 * 64; idx += NTHR) { const int d = idx >> 6, ee = idx & 63; sb[d * 65 + ee] = pool_s[g * 256 + d] * wb2[(size_t)(g * 256 + d) * DM + e0 + ee]; }
        __syncthreads();
        const int ee = tid >> 3, c8 = (tid & 7) * 8; float acc[8];
#pragma unroll
        for (int i = 0; i < 8; ++i) acc[i] = 0.f;
        for (int d = 0; d < 256; ++d) { const float b = sb[d * 65 + ee];
#pragma unroll
            for (int i = 0; i < 8; ++i) acc[i] += sa[(c8 + i) * 257 + d] * b; }
        *(u32x4*)(dst + (size_t)(e0 + ee) * DM + g * 256 + c0 + c8) = pack8(acc);
    }
}
DEVI void modp_job(const Params& p, float* modp, float* lds, int bid, int nb) {
    const int tid = opq_v(threadIdx.x);
    for (int unit = bid; unit < 2 * 16 * 12; unit += nb) {
        const int l = unit / 192, ks = (unit / 12) % 16, jb = unit % 12, j = jb * 512 + tid;
        __syncthreads();
        for (int idx = tid; idx < 9 * 64; idx += NTHR) { const int m = idx >> 6, kk = idx & 63; const float cv = m < 8 ? p.in[I_C][m * DM + ks * 64 + kk] : p.in[I_CCTX][ks * 64 + kk];
            lds[idx] = cv * sigmoidf_(cv); }
        __syncthreads();
        float acc[9];
#pragma unroll
        for (int m = 0; m < 9; ++m) acc[m] = 0.f;
        const float* w = p.in[I_WADA] + ((size_t)l * DM + ks * 64) * 6144 + j;
        for (int kk = 0; kk < 64; ++kk) { const float wv = w[(size_t)kk * 6144];
#pragma unroll
            for (int m = 0; m < 9; ++m) acc[m] += lds[m * 64 + kk] * wv; }
#pragma unroll
        for (int m = 0; m < 9; ++m) modp[(((size_t)l * 16 + ks) * 9 + m) * 6144 + j] = acc[m];
    }
}
DEVI void gen_filter(const Params& p, int l, int L, int mode, float* dst, float* lds, int bid, int nb) {
    const int tid = opq_v(threadIdx.x);
    float* feats = lds;
    float* h1 = lds + 32 * 33;
    float* h2 = h1 + 32 * 64;
    const float* w1 = p.in[I_HW1] + (size_t)l * 33 * 64; const float* b1 = p.in[I_HB1] + l * 64; const float* fq = p.in[I_HFREQ] + l * 64;
    const float* w2 = p.in[I_HW2] + (size_t)l * 64 * 64; const float* b2 = p.in[I_HB2] + l * 64; const float* w3 = p.in[I_HW3] + (size_t)l * 64 * 2048;
    const float inv_lm1 = 1.f / (float)(L - 1);
    for (int unit = bid; unit < L / 32; unit += nb) {
        const int t0 = unit * 32;
        __syncthreads();
        for (int idx = tid; idx < 32 * 33; idx += NTHR) { const int tt = idx / 33, f = idx % 33; const float tf = (float)(t0 + tt); float v;
            if (f == 0) v = tf * inv_lm1;
            else { const int bi = (f - 1) & 15; const float band = 1e-4f + (float)bi * ((15.f - 1e-4f) / 15.f); const float ang = (6.283185307179586f / (float)L) * tf * band; v = f <= 16 ? cosf(ang) : -sinf(ang); }
            feats[idx] = v; }
        __syncthreads();
#pragma unroll 1
        for (int k = 0; k < 4; ++k) { const int idx = tid + NTHR * k, tt = idx >> 6, j = idx & 63; float a = b1[j];
#pragma unroll 3
            for (int f = 0; f < 33; ++f) a += feats[tt * 33 + f] * w1[f * 64 + j];
            h1[idx] = sinf(fq[j] * a); }
        __syncthreads();
#pragma unroll 1
        for (int k = 0; k < 4; ++k) { const int idx = tid + NTHR * k, tt = idx >> 6, j = idx & 63; float a = b2[j];
#pragma unroll 8
            for (int i = 0; i < 64; ++i) a += h1[tt * 64 + i] * w2[i * 64 + j];
            h2[idx] = sinf(fq[j] * a); }
        __syncthreads();
        { const int wid = tid >> 6, lane = tid & 63, m = lane & 31, hi = lane >> 5;
          bf16x8 af[4];
#pragma unroll
          for (int kk = 0; kk < 4; ++kk) { float hv[8];
#pragma unroll
              for (int j = 0; j < 8; ++j) hv[j] = h2[m * 64 + 16 * kk + hi * 8 + j];
              const u32x4 pk = pack8(hv); af[kk] = *reinterpret_cast<const bf16x8*>(&pk); }
          const float dmin = -3.0701134573253946f, dmax = -15.350567286626973f;
#pragma unroll 1
          for (int tl = wid; tl < 64; tl += 8) {
              const int o = tl * 32 + m, isb = tl >> 5;
              f32x16 acc = {};
#pragma unroll
              for (int kk = 0; kk < 4; ++kk) { float wv[8];
#pragma unroll
                  for (int j = 0; j < 8; ++j) wv[j] = w3[(size_t)(16 * kk + hi * 8 + j) * 2048 + o];
                  const u32x4 pk = pack8(wv);
                  acc = __builtin_amdgcn_mfma_f32_32x32x16_bf16(*reinterpret_cast<const bf16x8*>(&pk), af[kk], acc, 0, 0, 0); }
              const int t = t0 + m; const float t01 = (float)t * inv_lm1;
#pragma unroll
              for (int r = 0; r < 16; ++r) { const int c = (tl * 32 + (r & 3) + 8 * (r >> 2) + 4 * hi) & 1023;
                  const float delta = fabsf(dmin + (float)c * ((dmax - dmin) / 1023.f)); const float val = acc[r] * (__expf(-t01 * delta) + 0.05f);
                  if (mode == 0) { if (!isb) dst[(size_t)c * FFTN + t] = val; else if (t > 0) dst[(size_t)c * FFTN + FFTN - t] = val; else dst[(size_t)c * FFTN + SEQ] = 0.f; }
                  else { if (!isb) dst[c * 512 + 256 + t] = val; else if (t > 0) dst[c * 512 + 256 - t] = val; else dst[c * 512] = 0.f; }
              }
          }
        }
    }
}
DEVI void kf_job(const float* kt, const float* hyd, unsigned* kf, char* ldsc, int bid, int nb) {
    const int tid = opq_v(threadIdx.x); float2* X = (float2*)ldsc; float2* tab = (float2*)(ldsc + FFTN * 8); float* red = (float*)(tab + 128);
    __syncthreads(); fft_tables(tab); __syncthreads();
    for (int u = bid; u < 512; u += nb) {
        const int c0 = 2 * u, c1 = c0 + 1;
        float ss0 = 0.f, ss1 = 0.f;
#pragma unroll 2
        for (int i = 0; i < 8; ++i) { const int t4 = (tid + NTHR * i) * 4; const f32x4 va = *(const f32x4*)(kt + (size_t)c0 * FFTN + t4), vb = *(const f32x4*)(kt + (size_t)c1 * FFTN + t4);
            ss0 += va[0] * va[0] + va[1] * va[1] + va[2] * va[2] + va[3] * va[3]; ss1 += vb[0] * vb[0] + vb[1] * vb[1] + vb[2] * vb[2] + vb[3] * vb[3];
            X[sw(t4)] = make_float2(va[0], vb[0]); X[sw(t4 + 1)] = make_float2(va[1], vb[1]); X[sw(t4 + 2)] = make_float2(va[2], vb[2]); X[sw(t4 + 3)] = make_float2(va[3], vb[3]); }
        const float tot0 = block_sum(ss0, red); const float tot1 = block_sum(ss1, red);
        const float sc0 = 0.5f * rsqrtf(tot0 + EPSF) * (1.f / FFTN), sc1 = 0.5f * rsqrtf(tot1 + EPSF) * (1.f / FFTN); const float dd0 = hyd[c0] * (1.f / FFTN), dd1 = hyd[c1] * (1.f / FFTN);
        fft_fwd(X, tab);
#pragma unroll 4
        for (int i = 0; i < 32; ++i) { const int pp = tid + NTHR * i; const int k = (int)(__brev((unsigned)pp) >> 18); const int pq = (int)(__brev((unsigned)((FFTN - k) & (FFTN - 1))) >> 18);
            const float2 xp = X[sw(pp)], xq = X[sw(pq)];
            kf[(size_t)c0 * FFTN + pp] = cvt_pk_bf16((xp.x + xq.x) * sc0 + dd0, (xp.y - xq.y) * sc0);
            kf[(size_t)c1 * FFTN + pp] = cvt_pk_bf16((xp.y + xq.y) * sc1 + dd1, (xq.x - xp.x) * sc1); }
        __syncthreads();
    }
}
DEVI void fftconv_job(const bf16_t* zt, bf16_t* zo, const unsigned* kf, char* ldsc, int bid, int nb) {
    const int tid = opq_v(threadIdx.x); float2* X = (float2*)ldsc; float2* tab = (float2*)(ldsc + FFTN * 8);
    __syncthreads(); fft_tables(tab); __syncthreads();
    for (int c = bid; c < 1024; c += nb) {
        const bf16_t* z0 = zt + (size_t)c * SEQ; const bf16_t* z1 = zt + (size_t)(1024 + c) * SEQ;
#pragma unroll
        for (int i = 0; i < 2; ++i) { const int t8 = (tid + NTHR * i) * 8; float a[8], b[8]; ld8bf(z0 + t8, a); ld8bf(z1 + t8, b);
#pragma unroll
            for (int e = 0; e < 8; ++e) X[sw(t8 + e)] = make_float2(a[e], b[e]); }
        __syncthreads();
        fft_r16_pass<10, false, 1>(X, tab); fft_r16_pass<6, false>(X, tab); fft_r16_pass<2, false>(X, tab);
        fft_mid_mul(X, kf + (size_t)c * FFTN);
        fft_r16_pass<2, true>(X, tab); fft_r16_pass<6, true>(X, tab); fft_r16_pass<10, true, 2>(X, tab);
#pragma unroll
        for (int i = 0; i < 2; ++i) { const int t8 = (tid + NTHR * i) * 8; float a[8], b[8];
#pragma unroll
            for (int e = 0; e < 8; ++e) { const float2 v = X[sw(t8 + e)]; a[e] = v.x; b[e] = v.y; }
            *(u32x4*)(zo + (size_t)c * SEQ + t8) = pack8(a); *(u32x4*)(zo + (size_t)(1024 + c) * SEQ + t8) = pack8(b); }
        __syncthreads();
    }
}
DEVI void ctxconv_job(bf16_t* zt, const float* kc, const float* hyd, float* lds, int bid, int nb) {
    const int tid = opq_v(threadIdx.x); float* zs = lds; float* ks = lds + 256; float* red = lds + 768;
    for (int unit = bid; unit < NBATCH * 1024; unit += nb) {
        const int c = unit & 1023; bf16_t* z = zt + (size_t)unit * 256;
        __syncthreads();
        const float kv = kc[c * 512 + tid]; ks[tid] = kv; if (tid < 256) zs[tid] = bf2f(z[tid]);
        const float tot = block_sum(kv * kv, red);
        const float nrm = rsqrtf(tot + EPSF);
        if (tid < 256) { float a = 0.f;
            for (int s = 0; s < 256; ++s) a += ks[256 + tid - s] * zs[s];
            z[tid] = (bf16_t)(cvt_pk_bf16(a * nrm + hyd[c] * zs[tid], 0.f) & 0xffffu); }
    }
    __syncthreads();
}

DEVI void headfix_job(const Params& p, const Chunk& ch, int l, int full, int bid, int nb) {
    const int tid = opq_v(threadIdx.x), li = tid & 15, grp = tid >> 4;
    bf16_t* P = (bf16_t*)(p.ws + OFF_P); bf16_t* kall = (bf16_t*)(p.ws + OFF_KALL);
    const float2* rope = (const float2*)(p.ws + OFF_ROPE);
    const int nh = full ? 10 : 2, npairs = ch.nrows * nh;
#pragma unroll 2
    for (int pb = bid * 32; pb < npairs; pb += nb * 32) {
        const int pi = pb + grp; const int r = pi / nh, hh = pi % nh + (full ? 0 : 8);
        float x[8]; ld8bf(P + (size_t)r * INW + hh * 128 + li * 8, x);
        float ss = 0.f;
#pragma unroll
        for (int i = 0; i < 8; ++i) ss += x[i] * x[i];
        ss += __shfl_xor(ss, 1); ss += __shfl_xor(ss, 2); ss += __shfl_xor(ss, 4); ss += __shfl_xor(ss, 8);
        const float rstd = rsqrtf(ss * (1.f / 128.f) + EPSF);
        const float* gw = (hh < 8 ? p.in[I_QG] : p.in[I_KG]) + l * 128 + li * 8;
        float y[8];
#pragma unroll
        for (int i = 0; i < 8; ++i) y[i] = x[i] * rstd * gw[i];
        if (!ch.isctx) {
            const int t = r & (SEQ - 1); const int pos = (li < 8) ? (t >> 6) : (t & 63); const int f0 = 8 * (li & 3);
#pragma unroll
            for (int i = 0; i < 8; ++i) { const float yp = __shfl_xor(y[i], 4); const float2 cs = rope[pos * 32 + f0 + i];
                y[i] = (li & 4) ? (y[i] * cs.x + yp * cs.y) : (y[i] * cs.x - yp * cs.y); }
        }
        if (hh < 8) {
#pragma unroll
            for (int i = 0; i < 8; ++i) y[i] *= 0.12751743082459868f; }
        const u32x4 w = pack8(y);
        if (hh < 8) *(u32x4*)(P + (size_t)r * INW + hh * 128 + li * 8) = w;
        else { const size_t kvrow = (size_t)(ch.b0 + (r >> ch.lgL)) * KVLEN + ch.koff + (r & (ch.L - 1)); *(u32x4*)(kall + kvrow * 256 + (hh - 8) * 128 + li * 8) = w; }
    }
}
DEVI void conv3x8(const bf16_t* P, int r, int t, int L, int colP, const float* cw, const float* cb, int colW, float* s) {
    float u0[8], u1[8], u2[8];
    ld8bf(P + (size_t)r * INW + colP, u1);
    if (t > 0) ld8bf(P + (size_t)(r - 1) * INW + colP, u0); else {
#pragma unroll
        for (int i = 0; i < 8; ++i) u0[i] = 0.f; }
    if (t < L - 1) ld8bf(P + (size_t)(r + 1) * INW + colP, u2); else {
#pragma unroll
        for (int i = 0; i < 8; ++i) u2[i] = 0.f; }
#pragma unroll
    for (int i = 0; i < 8; ++i) s[i] = cb[colW + i] + cw[colW + i] * u0[i] + cw[3072 + colW + i] * u1[i] + cw[6144 + colW + i] * u2[i];
}
DEVI void hypre_job(const Params& p, const Chunk& ch, int l, float* lds, int bid, int nb) {
    const int tid = opq_v(threadIdx.x); const bf16_t* P = (const bf16_t*)(p.ws + OFF_P); bf16_t* zt = (bf16_t*)(p.ws + OFF_ZT);
    const float* cw = p.in[I_HCW] + (size_t)l * 3 * 3072; const float* cb = p.in[I_HCB] + (size_t)l * 3072;
    const int ntiles = (ch.nrows / 64) * 8;
    for (int tile = bid; tile < ntiles; tile += nb) {
        const int r0 = (tile >> 3) * 64, c0 = (tile & 7) * 128, s = r0 >> ch.lgL, t0 = r0 & (ch.L - 1);
        __syncthreads();
#pragma unroll
        for (int k = 0; k < 2; ++k) { const int task = tid + NTHR * k, tt = task >> 4, cg8 = (task & 15) * 8, c = c0 + cg8;
            float sv[8], sx[8];
            conv3x8(P, r0 + tt, t0 + tt, ch.L, C_HY + c, cw, cb, c, sv);
            conv3x8(P, r0 + tt, t0 + tt, ch.L, C_HY + 2048 + c, cw, cb, 2048 + c, sx);
#pragma unroll
            for (int i = 0; i < 8; ++i) lds[(cg8 + i) * 65 + tt] = sv[i] * sx[i]; }
        __syncthreads();
#pragma unroll
        for (int k = 0; k < 2; ++k) { const int idx = tid + NTHR * k, row = idx >> 3, q8 = (idx & 7) * 8; float v[8];
#pragma unroll
            for (int e = 0; e < 8; ++e) v[e] = lds[row * 65 + q8 + e];
            *(u32x4*)(zt + ((size_t)(s * 1024 + c0 + row)) * ch.L + t0 + q8) = pack8(v); }
    }
}
DEVI void hypost_job(const Params& p, const Chunk& ch, int l, float* lds, int bid, int nb) {
    const int tid = opq_v(threadIdx.x); bf16_t* P = (bf16_t*)(p.ws + OFF_P); const bf16_t* zt = (const bf16_t*)(p.ws + OFF_ZT);
    const float* cw = p.in[I_HCW] + (size_t)l * 3 * 3072; const float* cb = p.in[I_HCB] + (size_t)l * 3072;
    const int ntiles = (ch.nrows / 64) * 8;
    for (int tile = bid; tile < ntiles; tile += nb) {
        const int r0 = (tile >> 3) * 64, c0 = (tile & 7) * 128, s = r0 >> ch.lgL, t0 = r0 & (ch.L - 1);
        __syncthreads();
#pragma unroll
        for (int k = 0; k < 2; ++k) { const int idx = tid + NTHR * k, row = idx >> 3, q8 = (idx & 7) * 8; float v[8];
            ld8bf(zt + ((size_t)(s * 1024 + c0 + row)) * ch.L + t0 + q8, v);
#pragma unroll
            for (int e = 0; e < 8; ++e) lds[row * 65 + q8 + e] = v[e]; }
        __syncthreads();
#pragma unroll
        for (int k = 0; k < 2; ++k) { const int task = tid + NTHR * k, tt = task >> 4, cg8 = (task & 15) * 8, c = c0 + cg8;
            float sx[8], o[8];
            conv3x8(P, r0 + tt, t0 + tt, ch.L, C_HY + 1024 + c, cw, cb, 1024 + c, sx);
#pragma unroll
            for (int i = 0; i < 8; ++i) o[i] = sx[i] * lds[(cg8 + i) * 65 + tt];
            *(u32x4*)(P + (size_t)(r0 + tt) * INW + C_HY + c) = pack8(o); }
    }
}
DEVI void poolpre_job(const Params& p, const Chunk& ch, int bid, int nb) {
    const int tid = opq_v(threadIdx.x); bf16_t* P = (bf16_t*)(p.ws + OFF_P);
    const int ntask = (ch.nrows / 16) * 128, L = ch.L;
    for (int task = bid * NTHR + tid; task < ntask; task += nb * NTHR) {
        const int run = task >> 7, c = (task & 127) * 8, gi = c >> 8, w = 2 << gi, before = w >> 1, after = w - 1 - before;
        const int r0 = run * 16, t0 = r0 & (L - 1), rs = r0 - t0;
        const bf16_t* base = P + (size_t)rs * INW + C_POOL + c;
        float S[8], u[8];
#pragma unroll
        for (int i = 0; i < 8; ++i) S[i] = 0.f;
        { const int lo = max(t0 - before, 0), hi = min(t0 + after, L - 1);
          for (int tt = lo; tt <= hi; ++tt) { ld8bf(base + (size_t)tt * INW, u);
#pragma unroll
              for (int i = 0; i < 8; ++i) S[i] += u[i]; } }
#pragma unroll 4
        for (int k = 0; k < 16; ++k) { const int t = t0 + k; const int lo = max(t - before, 0), hi = min(t + after + 1, L); const float rc = 1.f / (float)(hi - lo);
            ld8bf(base + (size_t)t * INW, u); float o[8];
#pragma unroll
            for (int i = 0; i < 8; ++i) o[i] = S[i] * rc - u[i];
            *(u32x4*)(P + (size_t)(r0 + k) * INW + C_HY + 2048 + c) = pack8(o);
            if (t + 1 + after < L) { ld8bf(base + (size_t)(t + 1 + after) * INW, u);
#pragma unroll
                for (int i = 0; i < 8; ++i) S[i] += u[i]; }
            if (t - before >= 0) { ld8bf(base + (size_t)(t - before) * INW, u);
#pragma unroll
                for (int i = 0; i < 8; ++i) S[i] -= u[i]; }
        }
    }
}
DEVI void ln_job(const Chunk& ch, const float* Y, const float* g, const float* b, float* xl, bf16_t* hdst, const float* mod, int shoff, int scoff, int bid, int nb) {
    const int tid = opq_v(threadIdx.x), wid = tid >> 6, lane = tid & 63;
    for (int r = bid * 8 + wid; r < ch.nrows; r += nb * 8) {
        const float* yp = Y + (size_t)r * DM; f32x4 v[4];
#pragma unroll
        for (int k = 0; k < 4; ++k) v[k] = *(const f32x4*)(yp + k * 256 + lane * 4);
        float s = 0.f;
#pragma unroll
        for (int k = 0; k < 4; ++k) s += v[k][0] + v[k][1] + v[k][2] + v[k][3];
        const float mu = wave_sum(s) * (1.f / DM);
        float q = 0.f;
#pragma unroll
        for (int k = 0; k < 4; ++k) { v[k] = v[k] - mu; q += v[k][0] * v[k][0] + v[k][1] * v[k][1] + v[k][2] * v[k][2] + v[k][3] * v[k][3]; }
        const float rstd = rsqrtf(wave_sum(q) * (1.f / DM) + EPSF);
        const int mi = ch.isctx ? 8 : ch.b0 + (r >> ch.lgL);
#pragma unroll
        for (int k = 0; k < 4; ++k) { const int c = k * 256 + lane * 4; const f32x4 gg = *(const f32x4*)(g + c), bb = *(const f32x4*)(b + c);
            const f32x4 o = v[k] * rstd * gg + bb;
            *(f32x4*)(xl + (size_t)r * DM + c) = o;
            if (hdst) { const f32x4 sc = *(const f32x4*)(mod + (size_t)mi * 6144 + scoff + c), sh = *(const f32x4*)(mod + (size_t)mi * 6144 + shoff + c);
                const f32x4 h = o * (sc + 1.f) + sh; u32x2 w; w.x = cvt_pk_bf16(h[0], h[1]); w.y = cvt_pk_bf16(h[2], h[3]);
                *(u32x2*)(hdst + (size_t)r * DM + c) = w; } }
    }
}

#define XB_TMO      128
#define XB_XCNT(j)  (256  + 64 * (j))
#define XB_XSUB(j)  (1280 + 64 * (j))
#define XB_XGEN(j)  (2304 + 64 * (j))
#define XB_TOP      3328
#define XB_TOPGEN   3392
#define XCD_BAR_WORDS 3456
#define XB_SPIN_CAP (1u << 20)
DEVI unsigned xb_ld(unsigned* p)              { return __hip_atomic_load(p, __ATOMIC_RELAXED, __HIP_MEMORY_SCOPE_AGENT); }
DEVI unsigned xb_add(unsigned* p, unsigned v) { return __hip_atomic_fetch_add(p, v, __ATOMIC_RELAXED, __HIP_MEMORY_SCOPE_AGENT); }
DEVI unsigned xb_xcc_id() { return (unsigned)__builtin_amdgcn_s_getreg((3 << 11) | 20) & 0xFu; }
#define XB_SPIN(cond, bar) do { unsigned _sp = 0; while (cond) { __builtin_amdgcn_s_sleep(1); \
    if ((++_sp & 255u) == 0u) { if (xb_ld(&(bar)[XB_TMO])) break; if (_sp > XB_SPIN_CAP) { atomicAdd(&(bar)[XB_TMO], 1u); break; } } } } while (0)
struct XcdBarrier { unsigned* bar; unsigned x; volatile LAS unsigned* st; };
DEVI XcdBarrier xcd_barrier_post(unsigned* bar, volatile LAS unsigned* st) {
    XcdBarrier b; b.bar = bar; b.x = xb_xcc_id(); b.st = st;
    if (threadIdx.x == 0) (void)xb_add(&bar[XB_XCNT(b.x)], 1u);
    return b;
}
DEVI void xcd_barrier_complete(unsigned* bar, unsigned x, unsigned& nloc, unsigned& nx) {
    const unsigned G = gridDim.x * gridDim.y * gridDim.z;
    unsigned sum, cnt, mine, sp = 0u;
    for (;;) {
        sum = 0u; cnt = 0u; mine = 0u;
#pragma unroll
        for (unsigned j = 0; j < 16; ++j) { const unsigned c = xb_ld(&bar[XB_XCNT(j)]); sum += c; cnt += (c > 0u) ? 1u : 0u; mine = (j == x) ? c : mine; }
        if (sum == G) break;
        __builtin_amdgcn_s_sleep(1);
        if ((++sp & 255u) == 0u) { if (xb_ld(&bar[XB_TMO])) break; if (sp > XB_SPIN_CAP) { atomicAdd(&bar[XB_TMO], 1u); break; } }
    }
    nloc = mine > 0u ? mine : 1u; nx = cnt > 0u ? cnt : 1u;
}
DEVI void xcd_barrier(const XcdBarrier& b) {
    asm volatile("s_waitcnt vmcnt(0)" ::: "memory");
    __syncthreads();
    if (threadIdx.x == 0) {
        unsigned* bar = b.bar;
        __builtin_amdgcn_s_waitcnt(0);
        unsigned nloc = b.st[0], nx = b.st[1];
        if (nloc == 0u) { xcd_barrier_complete(bar, b.x, nloc, nx); b.st[0] = nloc; b.st[1] = nx; }
        const unsigned old = xb_add(&bar[XB_XSUB(b.x)], 1u);
        const unsigned gen = old / nloc;
        if (old + 1u == (gen + 1u) * nloc) {
            __builtin_amdgcn_fence(__ATOMIC_RELEASE, "agent");
            asm volatile("s_waitcnt vmcnt(0)" ::: "memory");
            const unsigned og = xb_add(&bar[XB_TOP], 1u);
            const unsigned tg = og / nx;
            if (og + 1u == (tg + 1u) * nx) xb_add(&bar[XB_TOPGEN], 1u);
            else XB_SPIN(xb_ld(&bar[XB_TOPGEN]) == tg, bar);
            __builtin_amdgcn_fence(__ATOMIC_ACQUIRE, "agent");
            xb_add(&bar[XB_XGEN(b.x)], 1u);
            asm volatile("s_waitcnt vmcnt(0)" ::: "memory");
        } else {
            XB_SPIN(xb_ld(&bar[XB_XGEN(b.x)]) == gen, bar);
            __builtin_amdgcn_fence(__ATOMIC_ACQUIRE, "agent");
            asm volatile("s_waitcnt vmcnt(0)" ::: "memory");
        }
    }
    __syncthreads();
}

__global__ void __launch_bounds__(NTHR, 2) fwd_megakernel(Params p) {
    extern __shared__ __attribute__((aligned(16))) unsigned char lds[];
    cg::grid_group grid = cg::this_grid();
    const int bid = opq_s(blockIdx.x), nb = opq_s(gridDim.x), tid = opq_v(threadIdx.x);
    unsigned char* ws = p.ws;
    float* ldsf = (float*)lds;
    bf16_t* P = (bf16_t*)(ws + OFF_P);
    float* MOD = (float*)(ws + OFF_MOD);
    volatile LAS unsigned* xst = (volatile LAS unsigned*)(LAS unsigned char*)(lds + LDS_BYTES - 16);
    if (tid < 4) xst[tid] = 0u;
    if (bid == 0) for (int i = tid; i < XCD_BAR_WORDS; i += NTHR) __hip_atomic_store((unsigned*)(ws + OFF_BAR) + i, 0u, __ATOMIC_RELAXED, __HIP_MEMORY_SCOPE_AGENT);
    __syncthreads();

    for (int rep = 0; rep < 1 + PROBE_PREP; ++rep) {
    for (int l = 0; l < 2; ++l) {
        wt_transpose<0>(p.in[I_WIN] + (size_t)l * DM * INW, DM, INW, (bf16_t*)(ws + OFF_WIN + l * SZ_WIN), ldsf, bid, nb);
        wt_transpose<0>(p.in[I_WBR] + (size_t)(l * 3 + 0) * DM * DM, DM, DM, (bf16_t*)(ws + OFF_WBR + l * SZ_WBR), ldsf, bid, nb);
        wt_transpose<0>(p.in[I_WBR] + (size_t)(l * 3 + 1) * DM * DM, DM, DM, (bf16_t*)(ws + OFF_WBR + l * SZ_WBR) + (size_t)DM * DM, ldsf, bid, nb);
        wt_transpose<0>(p.in[I_WOUT] + (size_t)l * DM * DM, DM, DM, (bf16_t*)(ws + OFF_WOUT + l * SZ_WOUT), ldsf, bid, nb);
        wt_transpose<1>(p.in[I_FW1] + (size_t)l * DM * DFF, DM, DFF, (bf16_t*)(ws + OFF_W13 + l * SZ_W13), ldsf, bid, nb);
        wt_transpose<2>(p.in[I_FW3] + (size_t)l * DM * DFF, DM, DFF, (bf16_t*)(ws + OFF_W13 + l * SZ_W13), ldsf, bid, nb);
        wt_transpose<0>(p.in[I_FW2] + (size_t)l * DFF * DM, DFF, DM, (bf16_t*)(ws + OFF_W2 + l * SZ_W2), ldsf, bid, nb);
        wpc_job(p.in[I_POOLW] + (size_t)l * 4 * 256 * 256, p.in[I_POOLS] + l * DM, p.in[I_WBR] + (size_t)(l * 3 + 2) * DM * DM,
                (bf16_t*)(ws + OFF_WBR + l * SZ_WBR) + (size_t)2 * DM * DM, ldsf, bid, nb);
    }
    modp_job(p, (float*)(ws + OFF_MODP), ldsf, bid, nb);
    for (int idx = bid * NTHR + tid; idx < 128 * 32; idx += nb * NTHR) { const int pos = idx >> 5, f = idx & 31; const float inv = powf(10000.f, -(float)f / 32.f); float s, c; sincosf((float)pos * inv, &s, &c);
        ((float2*)(ws + OFF_ROPE))[idx] = make_float2(c, s); }
    gen_filter(p, 0, SEQ, 0, (float*)(ws + OFF_P), ldsf, bid, nb);
    gen_filter(p, 1, SEQ, 0, (float*)(ws + OFF_P) + (size_t)1024 * FFTN, ldsf, bid, nb);
    gen_filter(p, 0, CTXL, 1, (float*)(ws + OFF_KC), ldsf, bid, nb);
    }
    grid.sync();
    (void)xcd_barrier_post((unsigned*)(ws + OFF_BAR), xst);
    for (int rep = 0; rep < 1 + PROBE_PREP; ++rep) {
    for (int idx = bid * NTHR + tid; idx < 2 * 9 * 6144; idx += nb * NTHR) { const int l = idx / (9 * 6144), rem = idx % (9 * 6144), j = rem % 6144; float a = p.in[I_BADA][l * 6144 + j];
        for (int ks = 0; ks < 16; ++ks) a += ((const float*)(ws + OFF_MODP))[((size_t)l * 16 + ks) * 9 * 6144 + rem];
        MOD[idx] = a; }
    kf_job((const float*)(ws + OFF_P), p.in[I_HYD], (unsigned*)(ws + OFF_KF), (char*)lds, bid, nb);
    kf_job((const float*)(ws + OFF_P) + (size_t)1024 * FFTN, p.in[I_HYD] + DM, (unsigned*)(ws + OFF_KF + SZ_KF), (char*)lds, bid, nb);
    }
    GSYNC();
    for (int rep = 0; rep < 1 + PROBE_PREP; ++rep) {
    for (size_t i4 = (size_t)bid * NTHR + tid; i4 < (size_t)NTOK * DM / 4; i4 += (size_t)nb * NTHR) {
        const size_t e = i4 * 4; const int r = (int)(e >> 10), c = (int)(e & 1023);
        const bool isc = r >= NLAT; const int mi = isc ? 8 : (r >> 13);
        const f32x4 xv = isc ? *(const f32x4*)(p.in[I_CTX] + (e - (size_t)NLAT * DM)) : *(const f32x4*)(p.in[I_X] + e);
        const f32x4 sh = *(const f32x4*)(MOD + (size_t)mi * 6144 + c), sc = *(const f32x4*)(MOD + (size_t)mi * 6144 + 1024 + c);
        const f32x4 h = xv * (sc + 1.f) + sh; u32x2 w; w.x = cvt_pk_bf16(h[0], h[1]); w.y = cvt_pk_bf16(h[2], h[3]);
        *(u32x2*)((bf16_t*)(ws + OFF_H) + e) = w;
    }
    }
    GSYNC();

    for (int l_ = 0; l_ < 2; ++l_) {
        const int l = opq_s(l_);
        const float* modl = MOD + (size_t)l * 9 * 6144;
        const bf16_t* Wint = (const bf16_t*)(ws + OFF_WIN + l * SZ_WIN);
        const bf16_t* Wbr = (const bf16_t*)(ws + OFF_WBR + l * SZ_WBR);
        for (int grp_ = 0; grp_ < 3; ++grp_) {
            const int grp = opq_s(grp_);
            const int ci_lo = grp == 0 ? -1 : 2 * (grp - 1), ci_hi = grp == 0 ? 0 : ci_lo + 2;
            const int gfull = !(grp == 0 && l == 1);
          for (int ci_ = ci_lo; ci_ < ci_hi; ++ci_) {
            const int ci = opq_s(ci_);
            const Chunk ch = mk_chunk(ci, p);
            const int full = gfull;
            { pg8::Gemm g; g.a0 = g.a1 = g.a2 = 0u; g.bseg = 0; g.A = (const bf16_t*)(ws + OFF_H) + (size_t)ch.row0g * DM; g.lda = DM; g.K = DM; g.M = ch.nrows;
              EpiA E; E.P = P; E.vall = (bf16_t*)(ws + OFF_VALL); E.lgL = ch.lgL; E.Lm1 = ch.L - 1; E.b0 = ch.b0; E.koff = ch.koff;
              if (full) { g.Bt = Wint; g.N = INW; E.col_off = 0; } else { g.Bt = Wint + (size_t)C_K * DM; g.N = 512; E.col_off = C_K; }
              pg8::StaticOrder S; S.init(g.M, g.N, nb, bid, 1, 1);
              for (int rep = 0; rep < 1 + PROBE_GEMM; ++rep) pg8::gemm_phase<EpiA>((LAS unsigned char*)lds, g, S, E); }
            GSYNC();
            for (int rep = 0; rep < 1 + PROBE_EW; ++rep) {
            headfix_job(p, ch, l, full, bid, nb);
            if (full) hypre_job(p, ch, l, ldsf, bid, nb); }
            GSYNC();
            if (!full) continue;
            { const int nqb = ch.L / 256, nun = (ch.nrows / ch.L) * NHEAD * nqb;
              float gq = 0.f, gk = 0.f;
              for (int i = 0; i < HD; ++i) { gq = fmaxf(gq, fabsf(p.in[I_QG][l * HD + i])); gk = fmaxf(gk, fabsf(p.in[I_KG][l * HD + i])); }
              const float mshift = 11.313708498984761f * gq * gk * 1.02f;
              for (int u = bid; u < nun; u += nb) {
                  int qb = u % nqb, h = (u / nqb) % NHEAD, s = u / (nqb * NHEAD);
                  if (!ch.isctx && nb == 256) {
                      const int xcd = bid & 7, slot = bid >> 3, rnd = u >> 8, g4 = xcd & 3, sub = (xcd >> 2) + 2 * rnd;
                      s = g4 >> 1; h = (g4 & 1) * 4 + sub; qb = slot; }
                  const int b = ch.b0 + s;
                  bf16_t* Qb = P + (size_t)(s * ch.L + qb * 256) * INW + h * HD;
                  const bf16_t* Kh = (const bf16_t*)(ws + OFF_KALL) + (size_t)b * KVLEN * 256 + (h >> 2) * HD;
                  const bf16_t* Vh = (const bf16_t*)(ws + OFF_VALL) + (size_t)b * KVLEN * 256 + (h >> 2) * HD;
                  att::attn_dense_body(Qb, Kh, Vh, Qb, ch.isctx ? CTXL : KVLEN, INW, 256, INW, mshift, (char*)lds);
              } }
            if (ch.isctx) ctxconv_job((bf16_t*)(ws + OFF_ZT), (const float*)(ws + OFF_KC), p.in[I_HYD] + l * DM, ldsf, bid, nb);
            else fftconv_job((const bf16_t*)(ws + OFF_ZT), (bf16_t*)(ws + OFF_ZT), (const unsigned*)(ws + OFF_KF + l * SZ_KF), (char*)lds, bid, nb);
            GSYNC();
            for (int rep = 0; rep < 1 + PROBE_EW; ++rep) { hypost_job(p, ch, l, ldsf, bid, nb); poolpre_job(p, ch, bid, nb); }
            GSYNC();
            { pg8::Gemm g; g.K = DM; g.M = ch.nrows; g.N = DM; g.A = P; g.lda = INW; g.Bt = Wbr; g.a0 = C_HY * 2; g.a1 = C_Q * 2; g.a2 = (C_HY + 2048) * 2; g.bseg = (size_t)DM * DM * 2;
              pg8::StaticOrder S; S.init(g.M, g.N, nb, bid, 3);
              EpiMerge E; E.P = P; E.mg = (bf16_t*)(ws + OFF_R2) + (size_t)(ci < 0 ? 0 : (ci & 1)) * CH_ROWS * DM;
              __syncthreads();
              for (int rep = 0; rep < 1 + PROBE_GEMM; ++rep) pg8::gemm_phase<EpiMerge>((LAS unsigned char*)lds, g, S, E); }
            GSYNC();
          }
            if (!gfull) continue;
            Chunk sc = mk_chunk(ci_lo, p);
            if (grp > 0) sc.nrows = 2 * CH_ROWS;
            bf16_t* H2 = (bf16_t*)(ws + OFF_H) + (size_t)sc.row0g * DM;
            { pg8::Gemm g; g.a0 = g.a1 = g.a2 = 0u; g.bseg = 0; g.A = (const bf16_t*)(ws + OFF_R2); g.lda = DM; g.K = DM; g.M = sc.nrows; g.N = DM; g.Bt = (const bf16_t*)(ws + OFF_WOUT + l * SZ_WOUT);
              pg8::StaticOrder S; S.init(g.M, g.N, nb, bid);
              EpiRes E; E.xl = l == 0 ? (sc.isctx ? p.in[I_CTX] : p.in[I_X] + (size_t)sc.row0g * DM) : sc.xl; E.gmod = modl + 2048; E.Y = sc.xl; E.lgL = sc.lgL; E.b0 = sc.b0; E.isctx = sc.isctx;
              __syncthreads();
              for (int rep = 0; rep < 1 + PROBE_GEMM; ++rep) pg8::gemm_phase<EpiRes>((LAS unsigned char*)lds, g, S, E); }
            GSYNC();
            for (int rep = 0; rep < 1 + PROBE_EW; ++rep) ln_job(sc, sc.xl, p.in[I_LN1G] + l * DM, p.in[I_LN1B] + l * DM, sc.xl, H2, modl, 3072, 4096, bid, nb);
            GSYNC();
            { pg8::Gemm g; g.a0 = g.a1 = g.a2 = 0u; g.bseg = 0; g.A = H2; g.lda = DM; g.K = DM; g.M = sc.nrows; g.N = 2 * DFF; g.Bt = (const bf16_t*)(ws + OFF_W13 + l * SZ_W13);
              pg8::StaticOrder S; S.init(g.M, g.N, nb, bid);
              EpiF1 E; E.G = P;
              for (int rep = 0; rep < 1 + PROBE_GEMM; ++rep) pg8::gemm_phase<EpiF1>((LAS unsigned char*)lds, g, S, E); }
            GSYNC();
            { pg8::Gemm g; g.a0 = g.a1 = g.a2 = 0u; g.bseg = 0; g.A = P; g.lda = DFF; g.K = DFF; g.M = sc.nrows; g.N = DM; g.Bt = (const bf16_t*)(ws + OFF_W2 + l * SZ_W2);
              pg8::StaticOrder S; S.init(g.M, g.N, nb, bid);
              EpiRes E; E.xl = sc.xl; E.gmod = modl + 5120; E.Y = sc.xl; E.lgL = sc.lgL; E.b0 = sc.b0; E.isctx = sc.isctx;
              for (int rep = 0; rep < 1 + PROBE_GEMM; ++rep) pg8::gemm_phase<EpiRes>((LAS unsigned char*)lds, g, S, E); }
            GSYNC();
            for (int rep = 0; rep < 1 + PROBE_EW; ++rep) ln_job(sc, sc.xl, p.in[I_LN2G] + l * DM, p.in[I_LN2B] + l * DM, sc.xl, l == 0 ? H2 : (bf16_t*)nullptr,
                   MOD + (size_t)9 * 6144, 0, 1024, bid, nb);
            if (!(l == 1 && grp == 2)) GSYNC();
        }
    }
}

extern "C" void kernel_launch(void* const* d_in, const int* in_sizes, int n_in, void* d_out, int out_size, void* d_ws, size_t ws_size, hipStream_t stream) {
    static int grid_blocks = 0;
    if (grid_blocks == 0) {
        if (n_in != 29 || out_size != NLAT * DM || ws_size < WS_END) { fprintf(stderr, "kernel_launch: unexpected shapes (n_in %d out %d ws %zu need %zu)\n", n_in, out_size, ws_size, (size_t)WS_END); grid_blocks = -1; return; }
        int dev = 0, cus = 0, per_cu = 0;
        hipGetDevice(&dev);
        hipDeviceGetAttribute(&cus, hipDeviceAttributeMultiprocessorCount, dev);
        if (hipFuncSetAttribute((const void*)fwd_megakernel, hipFuncAttributeMaxDynamicSharedMemorySize, LDS_BYTES) != hipSuccess) { fprintf(stderr, "kernel_launch: hipFuncSetAttribute failed\n"); grid_blocks = -1; return; }
        if (hipOccupancyMaxActiveBlocksPerMultiprocessor(&per_cu, (const void*)fwd_megakernel, NTHR, LDS_BYTES) != hipSuccess || per_cu < 1) { fprintf(stderr, "kernel_launch: occupancy query failed (%d)\n", per_cu); per_cu = 1; (void)hipGetLastError(); }
        grid_blocks = cus * 1;
        (void)per_cu;
    }
    if (grid_blocks < 0) return;
    Params p{};
    for (int i = 0; i < 29; ++i) p.in[i] = (const float*)d_in[i];
    p.out = (float*)d_out; p.ws = (unsigned char*)d_ws;
    void* args[] = {&p};
    hipError_t e = hipLaunchCooperativeKernel((const void*)fwd_megakernel, dim3(grid_blocks), dim3(NTHR), args, LDS_BYTES, stream);
    if (e != hipSuccess) fprintf(stderr, "cooperative launch failed: %s (grid %d)\n", hipGetErrorString(e), grid_blocks);
}
```
